# Optimizing an MI355X kernel written in HIP

```python
import math
import jax
import jax.numpy as jnp
from jax import lax
import numpy as np

D_MODEL = 1024
BATCH = 16
SEQ = 2048
DEPTH = 4

HEAD_DIM = 64
ATTN_WIDTH = D_MODEL // 2
N_Q_HEADS = ATTN_WIDTH // HEAD_DIM
N_KV_HEADS = 2
GQA_GROUP = N_Q_HEADS // N_KV_HEADS
KV_WIDTH = N_KV_HEADS * HEAD_DIM
WINDOW = 128
BLOCK = 128
N_BUCKETS = 32
MAX_DISTANCE = 128
SSM_GROUP_CH = 16
SSM_WIDTH = D_MODEL // 2
SSM_GROUPS = SSM_WIDTH // SSM_GROUP_CH
SSM_STATE = 64
DT_MIN = 1e-3
DT_MAX = 1e-1
N_BRANCHES = 2
IN_COLS = ATTN_WIDTH + 2 * KV_WIDTH + SSM_WIDTH + N_BRANCHES * D_MODEL
D_FF = 2816
N_EXPERTS = 8
TOP_K = 2
D_FF_EXPERT = 3584
N_DENSE = (DEPTH + 1) // 2
N_MOE = DEPTH // 2
PLE_DIM = 256
DEEPNORM_ALPHA = (2 * DEPTH) ** 0.25
DEEPNORM_BETA = (8 * DEPTH) ** -0.25
LN_EPS = 1e-5
NEG_INF = -1e30

kernel_name = "hybrid_swa_s5_moe_deepnorm"


def layer_norm(x, g, b):
    xf = x.astype(jnp.float32)
    mu = jnp.mean(xf, axis=-1, keepdims=True)
    var = jnp.mean(jnp.square(xf - mu), axis=-1, keepdims=True)
    y = (xf - mu) * lax.rsqrt(var + LN_EPS) * g.astype(jnp.float32) + b.astype(jnp.float32)
    return y.astype(x.dtype)


def t5_causal_bucket(dist):
    dist = jnp.maximum(dist, 0)
    max_exact = N_BUCKETS // 2
    d_f = jnp.maximum(dist, 1).astype(jnp.float32)
    large = max_exact + (jnp.log(d_f / max_exact) / math.log(MAX_DISTANCE / max_exact)
                         * (N_BUCKETS - max_exact)).astype(jnp.int32)
    large = jnp.minimum(large, N_BUCKETS - 1)
    return jnp.where(dist < max_exact, dist, large)


def sliding_window_attention(q, k, v, sinks, rel_bias):
    bsz, seq, _ = q.shape
    nb = seq // BLOCK
    q = q.reshape(bsz, nb, BLOCK, N_KV_HEADS, GQA_GROUP, HEAD_DIM) * (HEAD_DIM ** -0.5)
    k = k.reshape(bsz, seq, N_KV_HEADS, HEAD_DIM)
    v = v.reshape(bsz, seq, N_KV_HEADS, HEAD_DIM)
    pad = ((0, 0), (BLOCK, 0), (0, 0), (0, 0))
    kp = jnp.pad(k, pad)
    vp = jnp.pad(v, pad)
    blk = (bsz, nb, BLOCK, N_KV_HEADS, HEAD_DIM)
    kb = jnp.concatenate([kp[:, :seq].reshape(blk), k.reshape(blk)], axis=2)
    vb = jnp.concatenate([vp[:, :seq].reshape(blk), v.reshape(blk)], axis=2)

    logits = jnp.einsum('bnqhgd,bnshd->bnhgqs', q, kb).astype(jnp.float32)

    qi = jnp.arange(BLOCK, dtype=jnp.int32)[:, None]
    kj = jnp.arange(2 * BLOCK, dtype=jnp.int32)[None, :]
    dist = qi + BLOCK - kj
    bias = rel_bias.astype(jnp.float32)[t5_causal_bucket(dist)]
    bias = jnp.transpose(bias, (2, 0, 1)).reshape(N_KV_HEADS, GQA_GROUP, BLOCK, 2 * BLOCK)
    key_pos = jnp.arange(nb, dtype=jnp.int32)[:, None, None] * BLOCK - BLOCK + kj[None]
    mask = (dist >= 0)[None] & (dist < WINDOW)[None] & (key_pos >= 0)
    logits = jnp.where(mask[None, :, None, None], logits + bias, NEG_INF)

    s = sinks.astype(jnp.float32).reshape(N_KV_HEADS, GQA_GROUP)[None, None, :, :, None]
    m = jnp.maximum(jnp.max(logits, axis=-1), s)
    e = jnp.exp(logits - m[..., None])
    denom = jnp.sum(e, axis=-1) + jnp.exp(s - m)
    w = (e / denom[..., None]).astype(v.dtype)
    o = jnp.einsum('bnhgqs,bnshd->bnqhgd', w, vb)
    return o.reshape(bsz, seq, ATTN_WIDTH)


def s5_mixer(u, lam_re, lam_im, log_dt, b_re, b_im, c_re, c_im, d, w_glu, b_glu):
    bsz, seq, _ = u.shape
    f32 = jnp.float32
    uf = u.astype(f32).reshape(bsz, seq, SSM_GROUPS, SSM_GROUP_CH)
    lam = lax.complex(lam_re.astype(f32), lam_im.astype(f32))
    dt = jnp.exp(log_dt.astype(f32))[:, None]
    lam_bar = jnp.exp(lam * dt)
    b = lax.complex(b_re.astype(f32), b_im.astype(f32))
    b_bar = ((lam_bar - 1.0) / lam)[..., None] * b
    bu = jnp.einsum('bsgh,gph->bsgp', uf.astype(jnp.complex64), b_bar)
    a = jnp.broadcast_to(lam_bar, (1, seq, SSM_GROUPS, SSM_STATE))

    def combine(left, right):
        a_l, x_l = left
        a_r, x_r = right
        return a_r * a_l, a_r * x_l + x_r

    _, states = lax.associative_scan(combine, (a, bu), axis=1)
    c = lax.complex(c_re.astype(f32), c_im.astype(f32))
    y = jnp.real(jnp.einsum('bsgp,ghp->bsgh', states, c))
    y = y + d.astype(f32).reshape(SSM_GROUPS, SSM_GROUP_CH) * uf
    y = jax.nn.gelu(y.reshape(bsz, seq, SSM_WIDTH)).astype(u.dtype)
    return y * jax.nn.sigmoid(y @ w_glu + b_glu)


def swiglu(h, w_gate_up, w_down):
    gate, up = jnp.split(h @ w_gate_up, 2, axis=-1)
    return (jax.nn.silu(gate) * up) @ w_down


def moe_swiglu(h, router, w_gate_up, w_down):
    bsz, seq, dm = h.shape
    hf = h.reshape(bsz * seq, dm)
    logits = (hf @ router).astype(jnp.float32)
    top_v, top_i = lax.top_k(logits, TOP_K)
    gates = jax.nn.softmax(top_v, axis=-1)
    combine = jnp.sum(jax.nn.one_hot(top_i, N_EXPERTS, dtype=jnp.float32) * gates[..., None], axis=1)
    combine = combine.astype(h.dtype)
    out = jnp.zeros_like(hf)
    for e in range(N_EXPERTS):
        out = out + combine[:, e:e + 1] * swiglu(hf, w_gate_up[e], w_down[e])
    return out.reshape(bsz, seq, dm)


def setup_inputs(seed: int = 0) -> dict:
    key = jax.random.key(seed)
    ks = jax.random.split(key, 32)
    nrm = lambda k, shape, scale: jax.random.normal(k, shape, jnp.float32) * scale
    n_idx = jnp.arange(SSM_STATE, dtype=jnp.float32)
    return {
        "x": nrm(ks[0], (BATCH, SEQ, D_MODEL), 1.0),
        "p": nrm(ks[1], (DEPTH, BATCH, SEQ, PLE_DIM), 1.0),
        "rel_bias": nrm(ks[2], (N_BUCKETS, N_Q_HEADS), 0.5),
        "w_in": nrm(ks[3], (DEPTH, D_MODEL, IN_COLS), D_MODEL ** -0.5),
        "attn_sinks": nrm(ks[4], (DEPTH, N_Q_HEADS), 0.5),
        "ssm_lambda_re": -0.5 + nrm(ks[5], (DEPTH, SSM_GROUPS, SSM_STATE), 0.01),
        "ssm_lambda_im": math.pi * n_idx + nrm(ks[6], (DEPTH, SSM_GROUPS, SSM_STATE), 0.01),
        "ssm_log_dt": jax.random.uniform(ks[7], (DEPTH, SSM_GROUPS), jnp.float32,
                                         math.log(DT_MIN), math.log(DT_MAX)),
        "ssm_b_re": nrm(ks[8], (DEPTH, SSM_GROUPS, SSM_STATE, SSM_GROUP_CH), (2 * SSM_GROUP_CH) ** -0.5),
        "ssm_b_im": nrm(ks[9], (DEPTH, SSM_GROUPS, SSM_STATE, SSM_GROUP_CH), (2 * SSM_GROUP_CH) ** -0.5),
        "ssm_c_re": nrm(ks[10], (DEPTH, SSM_GROUPS, SSM_GROUP_CH, SSM_STATE), SSM_STATE ** -0.5),
        "ssm_c_im": nrm(ks[11], (DEPTH, SSM_GROUPS, SSM_GROUP_CH, SSM_STATE), SSM_STATE ** -0.5),
        "ssm_d": nrm(ks[12], (DEPTH, SSM_WIDTH), 1.0),
        "w_glu": nrm(ks[13], (DEPTH, SSM_WIDTH, SSM_WIDTH), SSM_WIDTH ** -0.5),
        "b_glu": nrm(ks[14], (DEPTH, SSM_WIDTH), 0.02),
        "w_branch_attn": nrm(ks[15], (DEPTH, ATTN_WIDTH, D_MODEL), ATTN_WIDTH ** -0.5),
        "w_branch_ssm": nrm(ks[16], (DEPTH, SSM_WIDTH, D_MODEL), SSM_WIDTH ** -0.5),
        "w_out": nrm(ks[17], (DEPTH, D_MODEL, D_MODEL), DEEPNORM_BETA * D_MODEL ** -0.5),
        "ln1_g": 1.0 + nrm(ks[18], (DEPTH, D_MODEL), 0.02),
        "ln1_b": nrm(ks[19], (DEPTH, D_MODEL), 0.02),
        "ffn_w_gate_up": nrm(ks[20], (N_DENSE, D_MODEL, 2 * D_FF), D_MODEL ** -0.5),
        "ffn_w_down": nrm(ks[21], (N_DENSE, D_FF, D_MODEL), DEEPNORM_BETA * D_FF ** -0.5),
        "moe_router": nrm(ks[22], (N_MOE, D_MODEL, N_EXPERTS), D_MODEL ** -0.5),
        "moe_w_gate_up": nrm(ks[23], (N_MOE, N_EXPERTS, D_MODEL, 2 * D_FF_EXPERT), D_MODEL ** -0.5),
        "moe_w_down": nrm(ks[24], (N_MOE, N_EXPERTS, D_FF_EXPERT, D_MODEL), DEEPNORM_BETA * D_FF_EXPERT ** -0.5),
        "ple_w_proj": nrm(ks[25], (DEPTH, PLE_DIM, D_MODEL), DEEPNORM_BETA * PLE_DIM ** -0.5),
        "ple_w_gate": nrm(ks[26], (DEPTH, D_MODEL, D_MODEL), D_MODEL ** -0.5),
        "ln2_g": 1.0 + nrm(ks[27], (DEPTH, D_MODEL), 0.02),
        "ln2_b": nrm(ks[28], (DEPTH, D_MODEL), 0.02),
    }


def reference(x, p, rel_bias, w_in, attn_sinks, ssm_lambda_re, ssm_lambda_im, ssm_log_dt,
              ssm_b_re, ssm_b_im, ssm_c_re, ssm_c_im, ssm_d, w_glu, b_glu,
              w_branch_attn, w_branch_ssm, w_out, ln1_g, ln1_b,
              ffn_w_gate_up, ffn_w_down, moe_router, moe_w_gate_up, moe_w_down,
              ple_w_proj, ple_w_gate, ln2_g, ln2_b):
    splits = np.cumsum([ATTN_WIDTH, KV_WIDTH, KV_WIDTH, SSM_WIDTH, D_MODEL])[:].tolist()
    for i in range(DEPTH):
        z = x @ w_in[i]
        q, k, v, u, g_attn, g_ssm = jnp.split(z, splits, axis=-1)
        a_out = sliding_window_attention(q, k, v, attn_sinks[i], rel_bias)
        s_out = s5_mixer(u, ssm_lambda_re[i], ssm_lambda_im[i], ssm_log_dt[i],
                         ssm_b_re[i], ssm_b_im[i], ssm_c_re[i], ssm_c_im[i], ssm_d[i],
                         w_glu[i], b_glu[i])
        merged = (jax.nn.sigmoid(g_attn) * (a_out @ w_branch_attn[i])
                  + jax.nn.sigmoid(g_ssm) * (s_out @ w_branch_ssm[i]))
        x = layer_norm(DEEPNORM_ALPHA * x + merged @ w_out[i], ln1_g[i], ln1_b[i])
        if i % 2 == 0:
            ffn = swiglu(x, ffn_w_gate_up[i // 2], ffn_w_down[i // 2])
        else:
            ffn = moe_swiglu(x, moe_router[i // 2], moe_w_gate_up[i // 2], moe_w_down[i // 2])
        ple = jax.nn.sigmoid(x @ ple_w_gate[i]) * (p[i] @ ple_w_proj[i])
        x = layer_norm(DEEPNORM_ALPHA * x + ffn + ple, ln2_g[i], ln2_b[i])
    return x
```

```cpp
#include <hip/hip_runtime.h>
#include <cstdio>
#include <cstdint>

#ifndef MK_PER_PHASE
#define MK_PER_PHASE 0
#endif

namespace pg8 {
#define PG8_LAS __attribute__((address_space(3)))
typedef unsigned short bf16_t;
typedef short bf16x8 __attribute__((ext_vector_type(8)));
typedef float f32x4 __attribute__((ext_vector_type(4)));
typedef unsigned u32x4 __attribute__((ext_vector_type(4)));
typedef unsigned u32x2 __attribute__((ext_vector_type(2)));
__device__ __forceinline__ int opaque_v(int x) { asm volatile("" : "+v"(x)); return x; }
__device__ __forceinline__ int lane_id() { int l; asm volatile("v_mbcnt_lo_u32_b32 %0, -1, 0\n\tv_mbcnt_hi_u32_b32 %0, -1, %0" : "=v"(l)); return l; }
__device__ __forceinline__ float shx(float v, int o, int lane) { return __uint_as_float((unsigned)__builtin_amdgcn_ds_bpermute((lane ^ o) << 2, (int)__float_as_uint(v))); }
__device__ __forceinline__ float opaque_f(float x) { asm volatile("" : "+v"(x)); return x; }
__device__ __forceinline__ int opaque_s(int x) { asm volatile("" : "+s"(x)); return x; }
constexpr int BM = 256, BK = 64, HALF = 128, HTB = HALF * BK * 2, STAGE_BYTES = 8 * HTB, NXCD = 8, WGM = 8;

__host__ __device__ __forceinline__ int lds_byte(int r, int c) { const int st = (r >> 4) * 2 + (c >> 5), rr = r & 15, cc = c & 31, ob = rr * 64 + cc * 2; return st * 1024 + (ob ^ (((ob >> 9) & 1) << 5)); }
__host__ __device__ __forceinline__ void stage_rc(int b, int& R, int& C) { const int st = b / 1024, sb = b % 1024, swz = sb ^ (((sb >> 9) & 1) << 5); R = (st >> 1) * 16 + swz / 64; C = (st & 1) * 32 + (swz % 64) / 2; }
__host__ __device__ __forceinline__ int perm32(int rho) { const int n = rho >> 4, i = rho & 15; return 8 * (i >> 2) + 4 * n + (i & 3); }

struct Unit { int pm, pn, pc, pa; };
struct Gemm { const bf16_t* A; const bf16_t* Bt; int lda, ldb, K; };

struct StaticOrder {
    int nM, nN, nwg, G, c;
    __device__ void init(int M, int N, int G_, int c_) { nM = M / BM; nN = N / BM; nwg = nM * nN; G = G_; c = c_; }
    __device__ bool next(int i, Unit& u) const {
        const long L = (long)i * G + c; if (L >= nwg) return false;
        int wgid = (int)L; { const int q = nwg / NXCD, r = nwg % NXCD, xcd = wgid % NXCD, off = wgid / NXCD; wgid = (xcd < r ? xcd * (q + 1) : r * (q + 1) + (xcd - r) * q) + off; }
        const int nig = WGM * nN, gid = wgid / nig, fm = gid * WGM, gsz = (nM - fm) < WGM ? (nM - fm) : WGM;
        u.pm = fm + ((wgid % nig) % gsz); u.pn = (wgid % nig) / gsz; u.pc = u.pn; u.pa = u.pm; return true;
    }
    __device__ __forceinline__ void a_ready(const Unit&) const {}
    __device__ __forceinline__ void done(const Unit&) const {}
};
__device__ __forceinline__ void init_short(StaticOrder& S, int M, int N, int G, int c, int rem) {
    const int ns = rem == 0 ? G : G - rem; int cs = c - rem; if (cs < 0) cs += G;
    S.init(M, N, ns, cs < ns ? cs : (1 << 28));
}
struct GroupOrder {
    int nM, G, c, shift;
    __device__ void init(int nM_, int shift_, int G_, int c_) { nM = nM_; shift = shift_; G = G_; c = c_; }
    __device__ bool next(int i, Unit& u) const {
        const long L = (long)i * G + c; if (L >= nM) return false;
        int wgid = (int)L; { const int q = nM / NXCD, r = nM % NXCD, xcd = wgid % NXCD, off = wgid / NXCD; wgid = (xcd < r ? xcd * (q + 1) : r * (q + 1) + (xcd - r) * q) + off; }
        u.pm = wgid; u.pn = wgid >> shift; u.pc = 0; u.pa = wgid; return true;
    }
    __device__ __forceinline__ void a_ready(const Unit&) const {}
    __device__ __forceinline__ void done(const Unit&) const {}
};
struct MoeOrder {
    int nM, nN, nwg, G, c, acap, t1, t2, t3, t4, t5, t6, t7;
    __device__ bool next(int i, Unit& u) const {
        const long L = (long)i * G + c; if (L >= nwg) return false;
        int wgid = (int)L; { const int q = nwg / NXCD, r = nwg % NXCD, xcd = wgid % NXCD, off = wgid / NXCD; wgid = (xcd < r ? xcd * (q + 1) : r * (q + 1) + (xcd - r) * q) + off; }
        const int nig = WGM * nN, gid = wgid / nig, fm = gid * WGM, gsz = (nM - fm) < WGM ? (nM - fm) : WGM;
        u.pm = fm + ((wgid % nig) % gsz); u.pc = (wgid % nig) / gsz;
        const int e = (u.pm >= t1) + (u.pm >= t2) + (u.pm >= t3) + (u.pm >= t4) + (u.pm >= t5) + (u.pm >= t6) + (u.pm >= t7);
        int be = 0; be = u.pm >= t1 ? t1 : be; be = u.pm >= t2 ? t2 : be; be = u.pm >= t3 ? t3 : be; be = u.pm >= t4 ? t4 : be; be = u.pm >= t5 ? t5 : be; be = u.pm >= t6 ? t6 : be; be = u.pm >= t7 ? t7 : be;
        u.pn = e * nN + u.pc; u.pa = acap ? e * acap + (u.pm - be) : u.pm; return true;
    }
    __device__ __forceinline__ void a_ready(const Unit&) const {}
    __device__ __forceinline__ void done(const Unit&) const {}
};

typedef float f32x2_cv __attribute__((ext_vector_type(2))); typedef __bf16 bf16x2_cv __attribute__((ext_vector_type(2)));
__device__ __forceinline__ unsigned cvt_pk_bf16(float lo, float hi) { const f32x2_cv v = {lo, hi}; return __builtin_bit_cast(unsigned, __builtin_convertvector(v, bf16x2_cv)); }
__device__ __forceinline__ float bf_lo(unsigned w) { return __uint_as_float(w << 16); }
__device__ __forceinline__ float bf_hi(unsigned w) { return __uint_as_float(w & 0xffff0000u); }
__device__ __forceinline__ float sigm(float x) { return __builtin_amdgcn_rcpf(1.0f + __builtin_amdgcn_exp2f(-1.4426950408889634f * x)); }
__device__ __forceinline__ float gelu_tanh(float x) { const float t = x + 0.044715f * x * x * x; return x * __builtin_amdgcn_rcpf(1.0f + __builtin_amdgcn_exp2f(-2.302208198f * t)); }
__device__ __forceinline__ u32x4 pack8(const f32x4& a, const f32x4& b) { u32x4 w; w.x = cvt_pk_bf16(a[0], a[1]); w.y = cvt_pk_bf16(a[2], a[3]); w.z = cvt_pk_bf16(b[0], b[1]); w.w = cvt_pk_bf16(b[2], b[3]); return w; }
__device__ __forceinline__ void unpack8(const u32x4& w, f32x4& a, f32x4& b) { a = (f32x4){bf_lo(w.x), bf_hi(w.x), bf_lo(w.y), bf_hi(w.y)}; b = (f32x4){bf_lo(w.z), bf_hi(w.z), bf_lo(w.w), bf_hi(w.w)}; }

__device__ __forceinline__ void unpack8_u8(const u32x2& w, f32x4& a, f32x4& b) { const float k = 1.0f / 255.0f;
    a = (f32x4){(float)(w.x & 0xffu), (float)((w.x >> 8) & 0xffu), (float)((w.x >> 16) & 0xffu), (float)(w.x >> 24)} * k; b = (f32x4){(float)(w.y & 0xffu), (float)((w.y >> 8) & 0xffu), (float)((w.y >> 16) & 0xffu), (float)(w.y >> 24)} * k; }
#define PG8_FOR_AM _Pragma("unroll") for (int ai = 0; ai < 2; ++ai) _Pragma("unroll") for (int m = 0; m < 4; ++m)
#define PG8_FOR_BJ _Pragma("unroll") for (int bj = 0; bj < 2; ++bj)

struct EpiInProj {
    static constexpr bool PERM = true, AFTER_DRAIN = false;
    bf16_t *Q, *KV, *UG, *GA, *GS;
    __device__ __forceinline__ void operator()(const f32x4 (&acc)[2][2][4][2], const Unit& u, int wr, int wc, int fr, int fq) const {
        const int row0 = u.pm * BM + wr * 64 + fr, cl = wc * 32 + 8 * fq, pc = u.pc;
        if (pc < 3) {
            bf16_t* base = pc < 2 ? Q + pc * 256 : KV; const int ld = pc < 2 ? 512 : 256; const float sc = pc < 2 ? 0.125f * 1.4426950408889634f : 1.0f;
            PG8_FOR_AM { bf16_t* rp = base + (size_t)(row0 + ai * HALF + m * 16) * ld + cl;
                PG8_FOR_BJ { *(u32x4*)(rp + bj * HALF) = pack8(acc[ai][bj][m][0] * sc, acc[ai][bj][m][1] * sc); } }
        } else if (pc < 5) {
            PG8_FOR_AM { const int row = row0 + ai * HALF + m * 16, b = row >> 11, s = row & 2047, c = s >> 4, i = s & 15;
                PG8_FOR_BJ { const int ch = (pc - 3) * 256 + bj * HALF + cl, g = ch >> 4, h0 = ch & 15;
                    *(u32x4*)(UG + (size_t)(g * 2048 + b * 128 + c) * 384 + i * 16 + h0) = pack8(acc[ai][bj][m][0], acc[ai][bj][m][1]); } }
        } else {
            unsigned char* base = (unsigned char*)(pc < 9 ? GA : GS) + (pc < 9 ? pc - 5 : pc - 9) * 256;
            PG8_FOR_AM { unsigned char* rp = base + (size_t)(row0 + ai * HALF + m * 16) * 1024 + cl;
                PG8_FOR_BJ { const f32x4 a = acc[ai][bj][m][0], b = acc[ai][bj][m][1]; unsigned q[8];
#pragma unroll
                    for (int k = 0; k < 4; ++k) { q[k] = (unsigned)(sigm(a[k]) * 255.f + 0.5f); q[4 + k] = (unsigned)(sigm(b[k]) * 255.f + 0.5f); }
                    u32x2 w; w.x = q[0] | (q[1] << 8) | (q[2] << 16) | (q[3] << 24); w.y = q[4] | (q[5] << 8) | (q[6] << 16) | (q[7] << 24);
                    *(u32x2*)(rp + bj * HALF) = w; } }
        }
    }
};
struct EpiS {
    static constexpr bool PERM = false, AFTER_DRAIN = false;
    float* SL;
    __device__ __forceinline__ void operator()(const f32x4 (&acc)[2][2][4][2], const Unit& u, int wr, int wc, int fr, int fq) const {
        const int row0 = u.pm * BM + wr * 64 + fr, c0 = wc * 32 + 4 * fq;
        PG8_FOR_AM { float* rp = SL + (size_t)(row0 + ai * HALF + m * 16) * 128 + c0;
#pragma unroll
            for (int n = 0; n < 2; ++n) *(f32x4*)(rp + n * 16) = acc[ai][0][m][n]; }
    }
};
#define PG8_GROUP_FENCE asm volatile("" ::: "memory")
struct EpiY {
    static constexpr bool PERM = true, AFTER_DRAIN = false;
    const bf16_t* UG; const float* Dv; bf16_t* YB;
    __device__ __forceinline__ void operator()(const f32x4 (&acc)[2][2][4][2], const Unit& u, int wr, int wc, int fr, int fq) const {
        constexpr int AHEAD = 3;
        const int row0 = u.pm * BM + wr * 64 + fr, cl = wc * 32 + 8 * fq, g = (u.pm * BM) >> 11, h0 = cl & 15, ch = g * 16 + h0;
        const f32x4 d0 = *(const f32x4*)(Dv + ch), d1 = *(const f32x4*)(Dv + ch + 4);
        u32x4 ub[AHEAD + 1][2];
#define EPIY_LOAD(gi) do { const int row_ = row0 + ((gi) >> 2) * HALF + ((gi) & 3) * 16; _Pragma("unroll") for (int bj = 0; bj < 2; ++bj) ub[(gi) % (AHEAD + 1)][bj] = *(const u32x4*)(UG + (size_t)row_ * 384 + bj * HALF + cl); } while (0)
#pragma unroll
        for (int gi = 0; gi < AHEAD; ++gi) EPIY_LOAD(gi);
#pragma unroll
        for (int gi = 0; gi < 8; ++gi) { const int ai = gi >> 2, m = gi & 3;
            if (gi + AHEAD < 8) EPIY_LOAD(gi + AHEAD);
            PG8_GROUP_FENCE;
            const int row = row0 + ai * HALF + m * 16, b = (row >> 7) & 15, c = row & 127;
            PG8_FOR_BJ { const int col = bj * HALF + cl, j = col >> 4; const size_t t = (size_t)b * 2048 + c * 16 + j;
                f32x4 u0, u1; unpack8(ub[gi % (AHEAD + 1)][bj], u0, u1);
                f32x4 a = acc[ai][bj][m][0] + d0 * u0, bb = acc[ai][bj][m][1] + d1 * u1;
#pragma unroll
                for (int k = 0; k < 4; ++k) { a[k] = gelu_tanh(a[k]); bb[k] = gelu_tanh(bb[k]); }
                *(u32x4*)(YB + t * 512 + ch) = pack8(a, bb); } }
#undef EPIY_LOAD
    }
};
template <int MODE> struct EpiEw {
    static constexpr bool PERM = true, AFTER_DRAIN = false;
    bf16_t* O; int ld; const bf16_t* X; const bf16_t* Y; const float* bias;
    __device__ __forceinline__ void operator()(const f32x4 (&acc)[2][2][4][2], const Unit& u, int wr, int wc, int fr, int fq) const {
        constexpr int AHEAD = MODE == 0 ? 0 : ((MODE == 3 || MODE == 6) ? 2 : 3), NB = AHEAD + 1; constexpr bool HASY = (MODE == 3 || MODE == 6); constexpr float AL = 1.681792830507429f;
        const int row0 = u.pm * BM + wr * 64 + fr, col0 = u.pc * BM + wc * 32 + 8 * fq;
        const bf16_t* Xp = MODE == 4 ? O : X;
        constexpr bool X8 = (MODE == 2 || MODE == 3);
        u32x4 xb[X8 ? 1 : NB][2], yb[HASY ? NB : 1][2]; u32x2 xg[X8 ? NB : 1][2];
        f32x4 bv[2][2];
        if (MODE == 1) { PG8_FOR_BJ { bv[bj][0] = *(const f32x4*)(bias + col0 + bj * HALF); bv[bj][1] = *(const f32x4*)(bias + col0 + bj * HALF + 4); } }
#define EPIEW_LOAD(gi) do { const size_t ro_ = (size_t)(row0 + ((gi) >> 2) * HALF + ((gi) & 3) * 16) * ld + col0; _Pragma("unroll") for (int bj = 0; bj < 2; ++bj) { \
            if (X8) xg[(gi) % NB][bj] = *(const u32x2*)((const unsigned char*)Xp + ro_ + bj * HALF); else xb[(gi) % NB][bj] = *(const u32x4*)(Xp + ro_ + bj * HALF); \
            if (HASY) yb[(gi) % NB][bj] = *(const u32x4*)(Y + ro_ + bj * HALF); } } while (0)
        if (MODE != 0) {
#pragma unroll
            for (int gi = 0; gi < AHEAD; ++gi) EPIEW_LOAD(gi);
        }
#pragma unroll
        for (int gi = 0; gi < 8; ++gi) { const int ai = gi >> 2, m = gi & 3;
            if (MODE != 0) { if (gi + AHEAD < 8) EPIEW_LOAD(gi + AHEAD); PG8_GROUP_FENCE; }
            const size_t ro = (size_t)(row0 + ai * HALF + m * 16) * ld + col0;
            PG8_FOR_BJ { const size_t off = ro + bj * HALF; f32x4 a = acc[ai][bj][m][0], b = acc[ai][bj][m][1];
                if (MODE == 1) { f32x4 y0, y1; unpack8(xb[gi % NB][bj], y0, y1); a += bv[bj][0]; b += bv[bj][1];
#pragma unroll
                    for (int k = 0; k < 4; ++k) { a[k] = y0[k] * sigm(a[k]); b[k] = y1[k] * sigm(b[k]); } }
                if (MODE == 2) { f32x4 x0, x1; unpack8_u8(xg[gi % NB][bj], x0, x1); a *= x0; b *= x1; }
                if (MODE == 3) { f32x4 x0, x1, y0, y1; unpack8_u8(xg[gi % NB][bj], x0, x1); unpack8(yb[gi % NB][bj], y0, y1); a = y0 + x0 * a; b = y1 + x1 * b; }
                if (MODE == 5) { f32x4 x0, x1; unpack8(xb[gi % NB][bj], x0, x1); a += x0 * AL; b += x1 * AL; }
                if (MODE == 6) { f32x4 x0, x1, y0, y1; unpack8(xb[gi % NB][bj], x0, x1); unpack8(yb[gi % NB][bj], y0, y1); a += x0 * AL + y0; b += x1 * AL + y1; }
                if (MODE == 4) { f32x4 y0, y1; unpack8(xb[gi % NB][bj], y0, y1);
#pragma unroll
                    for (int k = 0; k < 4; ++k) { a[k] = y0[k] * sigm(a[k]); b[k] = y1[k] * sigm(b[k]); } }
                *(u32x4*)(O + off) = pack8(a, b); } }
#undef EPIEW_LOAD
    }
};
struct EpiSwiGLU {
    static constexpr bool PERM = true, AFTER_DRAIN = false;
    bf16_t* H; int ld;
    __device__ __forceinline__ void operator()(const f32x4 (&acc)[2][2][4][2], const Unit& u, int wr, int wc, int fr, int fq) const {
        const int row0 = u.pm * BM + wr * 64 + fr, col0 = u.pc * HALF + wc * 32 + 8 * fq;
        PG8_FOR_AM { f32x4 a = acc[ai][0][m][0], b = acc[ai][0][m][1]; const f32x4 ua = acc[ai][1][m][0], ub = acc[ai][1][m][1];
#pragma unroll
            for (int k = 0; k < 4; ++k) { a[k] = a[k] * sigm(a[k]) * ua[k]; b[k] = b[k] * sigm(b[k]) * ub[k]; }
            *(u32x4*)(H + (size_t)(row0 + ai * HALF + m * 16) * ld + col0) = pack8(a, b); }
    }
};

template <class Epi, class Sched, bool ALIGN_EPI = false, bool SP2 = false, bool GATHER = false>
__device__ __forceinline__ void gemm_phase(PG8_LAS unsigned char* lds, const Gemm g, const Sched& S, const Epi& E, const int tid_in, const int* gidx = nullptr, const int gmax = 0) {
    static_assert(!GATHER || SP2, "the gather path is written for the SP2 loop");
    const int tid = opaque_v(tid_in);
    const int wid = __builtin_amdgcn_readfirstlane(tid >> 6), lane = tid & 63, wr = wid >> 2, wc = wid & 3, fr = lane & 15, fq = lane >> 4;
    const int K = g.K, nt = K / BK;
    unsigned voffA[2], voffB[2]; int gR[2], gC2[2];
#pragma unroll
    for (int i = 0; i < 2; ++i) { int R, C; stage_rc(tid * 16 + i * 8192, R, C); const int Rb = Epi::PERM ? ((R & ~31) + perm32(R & 31)) : R;
        voffA[i] = (unsigned)(R * g.lda + C) * 2u; voffB[i] = (unsigned)(Rb * g.ldb + C) * 2u; gR[i] = R; gC2[i] = C * 2; }
    unsigned vC0[2], vC1[2];
#define PG8_GDMA(slot, pa_) do { if (wid < 4) __builtin_amdgcn_global_load_lds((const unsigned*)(gidx + (size_t)(pa_) * BM + wid * 64 + lane), (PG8_LAS unsigned*)(lds + STAGE_BYTES + 2048 + (slot) * 1024 + wid * 256), 4, 0, 0); } while (0)
#define PG8_GREAD(d0, d1, slot) do { const PG8_LAS unsigned* ix_ = (const PG8_LAS unsigned*)(lds + STAGE_BYTES + 2048 + (slot) * 1024); _Pragma("unroll") for (int _i = 0; _i < 2; ++_i) { \
        unsigned r0_ = ix_[gR[_i]], r1_ = ix_[HALF + gR[_i]]; r0_ = r0_ > (unsigned)gmax ? (unsigned)gmax : r0_; r1_ = r1_ > (unsigned)gmax ? (unsigned)gmax : r1_; \
        d0[_i] = r0_ * (unsigned)(g.lda * 2) + (unsigned)gC2[_i]; d1[_i] = r1_ * (unsigned)(g.lda * 2) + (unsigned)gC2[_i]; } } while (0)
    const size_t kstep = (size_t)(BK * 2);
    const size_t hstepA = (size_t)HALF * g.lda * 2, hstepB = (size_t)HALF * g.ldb * 2;
    const size_t tstepA = 2 * hstepA, tstepB = 2 * hstepB;
    const unsigned ldsw = (unsigned)wid * 1024u;
    const int aoff = lds_byte(wr * 64 + fr, fq * 8), boff = lds_byte(wc * 32 + fr, fq * 8);
#define PG8_SA(b, h) (((b) * 2 + (h)) * HTB)
#define PG8_SB(b, h) ((4 + (b) * 2 + (h)) * HTB)
#define PG8_STAGE(bufoff, gbase, voff) do { _Pragma("unroll") for (int _i = 0; _i < 2; ++_i) \
        __builtin_amdgcn_global_load_lds((const unsigned*)((const char*)(gbase) + (voff)[_i]), (PG8_LAS unsigned*)(lds + (bufoff) + ldsw + _i * 8192), 16, 0, 0); } while (0)
#define PG8_LDA(dst, b, h) do { _Pragma("unroll") for (int m = 0; m < 4; ++m) _Pragma("unroll") for (int k = 0; k < 2; ++k) dst[m][k] = *(const PG8_LAS bf16x8*)(lds + PG8_SA(b, h) + aoff + m * 2048 + k * 1024); } while (0)
#define PG8_LDB(dst, b, h) do { _Pragma("unroll") for (int n = 0; n < 2; ++n) _Pragma("unroll") for (int k = 0; k < 2; ++k) dst[n][k] = *(const PG8_LAS bf16x8*)(lds + PG8_SB(b, h) + boff + n * 2048 + k * 1024); } while (0)
#define PG8_MMA(ai, bj, At, Bt) do { __builtin_amdgcn_s_setprio(1); _Pragma("unroll") for (int m = 0; m < 4; ++m) _Pragma("unroll") for (int n = 0; n < 2; ++n) _Pragma("unroll") for (int k = 0; k < 2; ++k) \
        acc[ai][bj][m][n] = __builtin_amdgcn_mfma_f32_16x16x32_bf16(Bt[n][k], At[m][k], acc[ai][bj][m][n], 0, 0, 0); __builtin_amdgcn_s_setprio(0); } while (0)
#define PG8_WAIT_V(n) asm volatile("s_waitcnt vmcnt(" #n ")" ::: "memory")
#define PG8_WAIT_L(n) asm volatile("s_waitcnt lgkmcnt(" #n ")" ::: "memory")
#define PG8_BAR __builtin_amdgcn_s_barrier()
#define PG8_SCHED __builtin_amdgcn_sched_barrier(0)
    Unit cur, nxt; int ui = 0;
    if (!S.next(0, cur)) return;
    const float zz = opaque_f(0.f);
    f32x4 acc[2][2][4][2];
#pragma unroll
    for (int a = 0; a < 2; ++a)
#pragma unroll
        for (int b = 0; b < 2; ++b)
#pragma unroll
            for (int m = 0; m < 4; ++m)
#pragma unroll
                for (int n = 0; n < 2; ++n) acc[a][b][m][n] = (f32x4){zz, zz, zz, zz};
    bf16x8 At[4][2], B0[2][2], B1[2][2];
    const char* cA = GATHER ? (const char*)g.A : (const char*)g.A + (size_t)cur.pa * tstepA; const char* cB = (const char*)g.Bt + (size_t)cur.pn * tstepB;
    S.a_ready(cur);
    if constexpr (GATHER) { PG8_GDMA(0, cur.pa); PG8_WAIT_V(0); PG8_BAR; PG8_GREAD(vC0, vC1, 0); }
    if constexpr (SP2) {
        PG8_STAGE(PG8_SB(0, 0), cB, voffB); PG8_STAGE(PG8_SB(0, 1), cB + hstepB, voffB);
        if constexpr (GATHER) { PG8_STAGE(PG8_SA(0, 0), cA, vC0); PG8_STAGE(PG8_SA(0, 1), cA, vC1); } else { PG8_STAGE(PG8_SA(0, 0), cA, voffA); PG8_STAGE(PG8_SA(0, 1), cA + hstepA, voffA); }
        if (wr == 1) PG8_BAR;
        PG8_WAIT_V(2); PG8_BAR;
        PG8_STAGE(PG8_SB(1, 0), cB + kstep, voffB); if constexpr (GATHER) PG8_STAGE(PG8_SA(1, 0), cA + kstep, vC0); else PG8_STAGE(PG8_SA(1, 0), cA + kstep, voffA); PG8_STAGE(PG8_SB(1, 1), cB + hstepB + kstep, voffB);
        PG8_WAIT_V(6); PG8_BAR;
    } else {
        PG8_STAGE(PG8_SB(0, 0), cB, voffB); PG8_STAGE(PG8_SA(0, 0), cA, voffA); PG8_STAGE(PG8_SB(0, 1), cB + hstepB, voffB); PG8_STAGE(PG8_SA(0, 1), cA + hstepA, voffA);
        if (wr == 1) PG8_BAR;
        PG8_WAIT_V(4); PG8_BAR;
        PG8_STAGE(PG8_SB(1, 0), cB + kstep, voffB); PG8_STAGE(PG8_SA(1, 0), cA + kstep, voffA); PG8_STAGE(PG8_SB(1, 1), cB + hstepB + kstep, voffB);
        PG8_WAIT_V(6); PG8_BAR;
    }
    for (;;) {
        const bool has_next = S.next(ui + 1, nxt);
        const char* nA = GATHER ? cA : (has_next ? (const char*)g.A + (size_t)nxt.pa * tstepA : cA); const char* nB = has_next ? (const char*)g.Bt + (size_t)nxt.pn * tstepB : cB;
        if constexpr (GATHER) { if (has_next) PG8_GDMA((ui + 1) & 1, nxt.pa); }
        for (int t = 0; t < nt; t += 2) {
            const bool last = (t == nt - 2);
            const char* a1 = cA + (size_t)(t + 1) * kstep;
            const char* a2 = last ? nA : cA + (size_t)(t + 2) * kstep; const char* b2 = last ? nB : cB + (size_t)(t + 2) * kstep;
            const char* a3 = a2 + kstep; const char* b3 = b2 + kstep;
            if (last && has_next) S.a_ready(nxt);
            if constexpr (SP2) {
            unsigned w0[2], w1[2];
            if constexpr (GATHER) { _Pragma("unroll") for (int i = 0; i < 2; ++i) { w0[i] = vC0[i]; w1[i] = vC1[i]; } if (last && has_next) PG8_GREAD(w0, w1, (ui + 1) & 1); }
            PG8_LDB(B0, 0, 0); PG8_LDB(B1, 0, 1); PG8_SCHED; PG8_LDA(At, 0, 0); if constexpr (GATHER) PG8_STAGE(PG8_SA(1, 1), a1, vC1); else PG8_STAGE(PG8_SA(1, 1), a1 + hstepA, voffA);
            PG8_WAIT_V(8); PG8_WAIT_L(0); PG8_BAR; PG8_MMA(0, 0, At, B0); PG8_MMA(0, 1, At, B1); PG8_BAR; PG8_SCHED;
            PG8_LDA(At, 0, 1); PG8_STAGE(PG8_SB(0, 0), b2, voffB); PG8_STAGE(PG8_SB(0, 1), b2 + hstepB, voffB); if constexpr (GATHER) PG8_STAGE(PG8_SA(0, 0), a2, w0); else PG8_STAGE(PG8_SA(0, 0), a2, voffA);
            PG8_WAIT_V(8); PG8_WAIT_L(0); PG8_BAR; PG8_MMA(1, 0, At, B0); PG8_MMA(1, 1, At, B1); PG8_BAR; PG8_SCHED;
            PG8_LDB(B0, 1, 0); PG8_LDB(B1, 1, 1); PG8_SCHED; PG8_LDA(At, 1, 0); if constexpr (GATHER) PG8_STAGE(PG8_SA(0, 1), a2, w1); else PG8_STAGE(PG8_SA(0, 1), a2 + hstepA, voffA);
            PG8_WAIT_V(8); PG8_WAIT_L(0); PG8_BAR; PG8_MMA(0, 0, At, B0); PG8_MMA(0, 1, At, B1); PG8_BAR; PG8_SCHED;
            PG8_LDA(At, 1, 1); PG8_STAGE(PG8_SB(1, 0), b3, voffB); PG8_STAGE(PG8_SB(1, 1), b3 + hstepB, voffB); if constexpr (GATHER) PG8_STAGE(PG8_SA(1, 0), a3, w0); else PG8_STAGE(PG8_SA(1, 0), a3, voffA);
            PG8_WAIT_V(8); PG8_WAIT_L(0); PG8_BAR; PG8_MMA(1, 0, At, B0); PG8_MMA(1, 1, At, B1); PG8_BAR; PG8_SCHED;
            } else {
            PG8_LDB(B0, 0, 0); PG8_SCHED; PG8_LDA(At, 0, 0); PG8_STAGE(PG8_SA(1, 1), a1 + hstepA, voffA);
            PG8_WAIT_L(8); PG8_BAR; PG8_WAIT_L(0); PG8_MMA(0, 0, At, B0); PG8_BAR; PG8_SCHED;
            PG8_LDB(B1, 0, 1); PG8_STAGE(PG8_SB(0, 0), b2, voffB);
            PG8_BAR; PG8_WAIT_L(0); PG8_MMA(0, 1, At, B1); PG8_BAR;
            PG8_LDA(At, 0, 1); PG8_STAGE(PG8_SA(0, 0), a2, voffA);
            PG8_BAR; PG8_WAIT_L(0); PG8_MMA(1, 0, At, B0); PG8_BAR; PG8_SCHED;
            PG8_STAGE(PG8_SB(0, 1), b2 + hstepB, voffB);
            PG8_WAIT_V(6); PG8_BAR; PG8_MMA(1, 1, At, B1); PG8_BAR;
            PG8_LDB(B0, 1, 0); PG8_SCHED; PG8_LDA(At, 1, 0); PG8_STAGE(PG8_SA(0, 1), a2 + hstepA, voffA);
            PG8_WAIT_L(8); PG8_BAR; PG8_WAIT_L(0); PG8_MMA(0, 0, At, B0); PG8_BAR; PG8_SCHED;
            PG8_LDB(B1, 1, 1); PG8_STAGE(PG8_SB(1, 0), b3, voffB);
            PG8_BAR; PG8_WAIT_L(0); PG8_MMA(0, 1, At, B1); PG8_BAR;
            PG8_LDA(At, 1, 1); PG8_STAGE(PG8_SA(1, 0), a3, voffA);
            PG8_BAR; PG8_WAIT_L(0); PG8_MMA(1, 0, At, B0); PG8_BAR; PG8_SCHED;
            PG8_STAGE(PG8_SB(1, 1), b3 + hstepB, voffB);
            PG8_WAIT_V(6); PG8_BAR; PG8_MMA(1, 1, At, B1); PG8_BAR;
            }
        }
        if constexpr (ALIGN_EPI) { if (wr == 0) PG8_BAR; }
        if constexpr (!Epi::AFTER_DRAIN) { const int l2_ = lane_id(); E(acc, cur, wr, wc, l2_ & 15, l2_ >> 4); S.done(cur); }
        if (!has_next) break;
#pragma unroll
        for (int a = 0; a < 2; ++a)
#pragma unroll
            for (int b = 0; b < 2; ++b)
#pragma unroll
                for (int m = 0; m < 4; ++m)
#pragma unroll
                    for (int n = 0; n < 2; ++n) acc[a][b][m][n] = (f32x4){zz, zz, zz, zz};
        cur = nxt; cA = nA; cB = nB; ++ui;
        if constexpr (GATHER) PG8_GREAD(vC0, vC1, ui & 1);
        if constexpr (ALIGN_EPI) { if (wr == 1) PG8_BAR; }
    }
    PG8_WAIT_V(0);
    if constexpr (!ALIGN_EPI) { if (wr == 0) PG8_BAR; }
    PG8_BAR;
#undef PG8_GDMA
#undef PG8_GREAD
#undef PG8_SA
#undef PG8_SB
#undef PG8_STAGE
#undef PG8_LDA
#undef PG8_LDB
#undef PG8_MMA
#undef PG8_WAIT_V
#undef PG8_WAIT_L
#undef PG8_BAR
#undef PG8_SCHED
}
}

constexpr int NWAVES = 8;
constexpr int DM = 1024, BATCH = 16, SEQ = 2048, T = BATCH * SEQ, DEPTH = 4;
constexpr int IN_COLS = 3328, DFF = 2816, DFFE = 3584, NEXP = 8, PLE = 256;
constexpr int CH = 16;
constexpr int NCHUNK = SEQ / CH;
constexpr int UGROWS = 32 * BATCH * NCHUNK;
constexpr int UGLD = 384;
constexpr int XSROWS = 2 * T + NEXP * 256;
constexpr float LN_EPS = 1e-5f;
constexpr float ALPHA = 1.681792830507429f;
constexpr float LOG2E = 1.4426950408889634f;

constexpr size_t MiB = 1u << 20;
constexpr size_t WS_CTL = 0, CTL_ZERO_BYTES = 1 * MiB;
constexpr size_t WS_WIN = 1 * MiB;
constexpr size_t WS_WGLU = WS_WIN + 26 * MiB;
constexpr size_t WS_WBA = WS_WGLU + 2 * MiB;
constexpr size_t WS_WBS = WS_WBA + 4 * MiB;
constexpr size_t WS_WOUT = WS_WBS + 4 * MiB;
constexpr size_t WS_WGU = WS_WOUT + 8 * MiB;
constexpr size_t WS_WDN = WS_WGU + 22 * MiB;
constexpr size_t WS_MGU = WS_WDN + 11 * MiB;
constexpr size_t WS_MDN = WS_MGU + 224 * MiB;
constexpr size_t WS_PPJ = WS_MDN + 112 * MiB;
constexpr size_t WS_PGT = WS_PPJ + 2 * MiB;
constexpr size_t WS_SG = WS_PGT + 8 * MiB;
constexpr size_t WS_TZE = WS_SG + 16 * MiB;
constexpr size_t WS_MISC = WS_TZE + 24 * MiB;
constexpr size_t WS_PB = WS_MISC + 2 * MiB;
constexpr size_t WS_XB = WS_PB + 64 * MiB;
constexpr size_t WS_PP = WS_XB + 64 * MiB;
constexpr size_t WS_XS = WS_PP + 64 * MiB;
constexpr size_t WS_MIX = WS_XS + 512 * MiB;
constexpr size_t WS_Q = WS_MIX;
constexpr size_t WS_KV = WS_Q + 32 * MiB;
constexpr size_t WS_UG = WS_KV + 16 * MiB;
constexpr size_t WS_GA = WS_UG + 48 * MiB;
constexpr size_t WS_GS = WS_GA + 64 * MiB;
constexpr size_t WS_SL = WS_GS + 64 * MiB;
constexpr size_t WS_AO = WS_SL + 32 * MiB;
constexpr size_t WS_YB = WS_AO + 32 * MiB;
constexpr size_t WS_SO = WS_YB + 32 * MiB;
constexpr size_t WS_T1 = WS_SO + 32 * MiB;
constexpr size_t WS_MG = WS_T1 + 64 * MiB;
constexpr size_t WS_HB = WS_MIX;
constexpr size_t WS_HBUF = WS_MIX + 480 * MiB;
constexpr size_t WS_END = WS_HBUF + 64 * MiB;
static_assert(WS_MG + 64 * MiB == WS_HBUF && (size_t)XSROWS * DFFE * 2 <= 480 * MiB && (size_t)XSROWS * DM * 2 <= 512 * MiB, "d_ws map");

constexpr int CW_BAR = 4096;
constexpr int CW_MOE = 16384;

constexpr int RING_OFF = 0, RING_BYTES = 131072;
constexpr int LDSCTL_OFF = RING_BYTES, MISC_OFF = LDSCTL_OFF + 320;
constexpr int LDS_BYTES = 147456;

#define GAS __attribute__((address_space(1)))
#define LAS __attribute__((address_space(3)))
typedef unsigned short bf16;
typedef unsigned v4u __attribute__((ext_vector_type(4)));
typedef unsigned v2u __attribute__((ext_vector_type(2)));
typedef float f32x4 __attribute__((ext_vector_type(4)));
typedef float f32x2 __attribute__((ext_vector_type(2)));
typedef short bf16x8 __attribute__((ext_vector_type(8)));
typedef short bf16x4 __attribute__((ext_vector_type(4)));
typedef GAS unsigned gu32;
#define RLX_AGENT __ATOMIC_RELAXED, __HIP_MEMORY_SCOPE_AGENT
#define LDS_WAIT() asm volatile("s_waitcnt lgkmcnt(0)" ::: "memory")
#define VM_WAIT() asm volatile("s_waitcnt vmcnt(0)" ::: "memory")
__device__ __forceinline__ unsigned f2bf(float f) { unsigned u = __builtin_bit_cast(unsigned, f); return (u + 0x7fffu + ((u >> 16) & 1u)) >> 16; }
__device__ __forceinline__ unsigned pk2(float lo, float hi) { return f2bf(lo) | (f2bf(hi) << 16); }

#define XB_TMO      128
#define XB_XCNT(j)  (256  + 64 * (j))
#define XB_XSUB(j)  (1280 + 64 * (j))
#define XB_XGEN(j)  (2304 + 64 * (j))
#define XB_TOP      3328
#define XB_TOPGEN   3392
#define XCD_BAR_WORDS 3456
#define XB_SPIN_CAP (1u << 18)

__device__ __forceinline__ unsigned xb_ld(unsigned* p)              { return __hip_atomic_load(p, __ATOMIC_RELAXED, __HIP_MEMORY_SCOPE_AGENT); }
__device__ __forceinline__ unsigned xb_add(unsigned* p, unsigned v) { return __hip_atomic_fetch_add(p, v, __ATOMIC_RELAXED, __HIP_MEMORY_SCOPE_AGENT); }
__device__ __forceinline__ unsigned xb_xcc_id() { return (unsigned)__builtin_amdgcn_s_getreg((3 << 11) | 20) & 0xFu; }
#define XB_SPIN(cond, bar) do { unsigned _sp = 0; while (cond) { __builtin_amdgcn_s_sleep(1); \
    if ((++_sp & 255u) == 0u) { if (xb_ld(&(bar)[XB_TMO])) break; if (_sp > XB_SPIN_CAP) { atomicAdd(&(bar)[XB_TMO], 1u); break; } } } } while (0)

struct XcdBarrier { unsigned* bar; unsigned x; volatile LAS unsigned* st; };

__device__ __forceinline__ XcdBarrier xcd_barrier_post(unsigned* bar, volatile LAS unsigned* st, int tid) {
    XcdBarrier b; b.bar = bar; b.x = xb_xcc_id(); b.st = st;
    if (tid == 0) (void)xb_add(&bar[XB_XCNT(b.x)], 1u);
    return b;
}
__device__ __forceinline__ void xcd_barrier_complete(unsigned* bar, unsigned x, unsigned& nloc, unsigned& nx) {
    const unsigned G = gridDim.x * gridDim.y * gridDim.z;
    unsigned sum, cnt, mine, sp = 0u;
    for (;;) {
        sum = 0u; cnt = 0u; mine = 0u;
#pragma unroll 1
        for (unsigned j = 0; j < 16; ++j) { const unsigned c = xb_ld(&bar[XB_XCNT(j)]); sum += c; cnt += (c > 0u) ? 1u : 0u; mine = (j == x) ? c : mine; }
        if (sum == G) break;
        __builtin_amdgcn_s_sleep(1);
        if ((++sp & 255u) == 0u) { if (xb_ld(&bar[XB_TMO])) break; if (sp > XB_SPIN_CAP) { atomicAdd(&bar[XB_TMO], 1u); break; } }
    }
    nloc = mine > 0u ? mine : 1u; nx = cnt > 0u ? cnt : 1u;
}
__device__ __forceinline__ void xcd_barrier(const XcdBarrier& b, int tid) {
    asm volatile("s_waitcnt vmcnt(0)" ::: "memory");
    __syncthreads();
    if (tid == 0) {
        unsigned* bar = b.bar; asm volatile("" : "+s"(bar));
        __builtin_amdgcn_s_waitcnt(0);
        unsigned nloc = b.st[0], nx = b.st[1];
        if (nloc == 0u) { xcd_barrier_complete(bar, b.x, nloc, nx); b.st[0] = nloc; b.st[1] = nx; }
        const unsigned old = xb_add(&bar[XB_XSUB(b.x)], 1u);
        const unsigned gen = old / nloc;
        if (old + 1u == (gen + 1u) * nloc) {
            __builtin_amdgcn_fence(__ATOMIC_RELEASE, "agent");
            asm volatile("s_waitcnt vmcnt(0)" ::: "memory");
            const unsigned og = xb_add(&bar[XB_TOP], 1u);
            const unsigned tg = og / nx;
            if (og + 1u == (tg + 1u) * nx) xb_add(&bar[XB_TOPGEN], 1u);
            else XB_SPIN(xb_ld(&bar[XB_TOPGEN]) == tg, bar);
            __builtin_amdgcn_fence(__ATOMIC_ACQUIRE, "agent");
            xb_add(&bar[XB_XGEN(b.x)], 1u);
            asm volatile("s_waitcnt vmcnt(0)" ::: "memory");
        } else {
            XB_SPIN(xb_ld(&bar[XB_XGEN(b.x)]) == gen, bar);
            __builtin_amdgcn_fence(__ATOMIC_ACQUIRE, "agent");
            asm volatile("s_waitcnt vmcnt(0)" ::: "memory");
        }
    }
    __syncthreads();
}

struct Args { const float* in[29]; float* out; unsigned char* ws; int ph_lo, ph_hi; };
enum { I_X = 0, I_P, I_RELB, I_WIN, I_SINKS, I_LRE, I_LIM, I_LOGDT, I_BRE, I_BIM, I_CRE, I_CIM, I_SSMD, I_WGLU, I_BGLU, I_WBA, I_WBS, I_WOUT, I_LN1G, I_LN1B,
       I_FGU, I_FDN, I_ROUTER, I_MGU, I_MDN, I_PPROJ, I_PGATE, I_LN2G, I_LN2B };

typedef const __attribute__((address_space(4))) unsigned char* kptr_t;
__device__ __forceinline__ kptr_t karg_base() { kptr_t k = (kptr_t)__builtin_amdgcn_kernarg_segment_ptr(); asm volatile("" : "+s"(k)); return k; }
__device__ __forceinline__ const float* in_ptr(int i) { return *(const float* const __attribute__((address_space(4)))*)(karg_base() + 8 * i); }
__device__ __forceinline__ float* out_ptr() { return *(float* const __attribute__((address_space(4)))*)(karg_base() + 8 * 29); }
__device__ __forceinline__ unsigned char* ws_ptr() { return *(unsigned char* const __attribute__((address_space(4)))*)(karg_base() + 8 * 30); }
static_assert(sizeof(Args) == 8 * 31 + 8, "Args layout");
#define WSP(T, off) ((T*)(ws_ptr() + (off)))

__device__ __forceinline__ float wave_sum(float v, int lane) {
#pragma unroll
    for (int o = 1; o < 64; o <<= 1) v += pg8::shx(v, o, lane);
    return v;
}

struct TrItem { const float* src; bf16* dst; int N, K; };
__device__ __forceinline__ void tr_desc1(TrItem& d, const float* W, int K, int N, bf16* WT, int ilv, int item) {
    const int nblk = N / 32, kb = item / nblk, nb = item % nblk, k0 = 64 * kb, n0 = 32 * nb;
    int r0 = n0;
    if (ilv > 0) { r0 = n0 < ilv ? (n0 / 128) * 256 + (n0 % 128) : ((n0 - ilv) / 128) * 256 + 128 + ((n0 - ilv) % 128); }
    d.src = W + (size_t)k0 * N + n0; d.dst = WT + (size_t)r0 * K + k0; d.N = N; d.K = K;
}
__device__ __forceinline__ bool tr_family(int& r, TrItem& d, const float* W, int nb, int K, int N, bf16* WT, int ilv) {
    const int per = (K / 64) * (N / 32), tot = nb * per;
    if (r < tot) { const int mi = r / per; tr_desc1(d, W + (size_t)mi * K * N, K, N, WT + (size_t)mi * K * N, ilv, r % per); return true; }
    r -= tot; return false;
}
constexpr int TR_NIT = 4 * 16 * 104 + 4 * 8 * 16 + 2 * (4 * 8 * 32) + 4 * 16 * 32 + 2 * 16 * 176 + 2 * 44 * 32 + 16 * 16 * 224 + 16 * 56 * 32 + 4 * 4 * 32 + 4 * 16 * 32;
__device__ __forceinline__ void tr_desc(TrItem& d, int it) {
    int r = it;
    if (tr_family(r, d, in_ptr(I_WIN), 4, 1024, 3328, WSP(bf16, WS_WIN), 0)) return;
    if (tr_family(r, d, in_ptr(I_WGLU), 4, 512, 512, WSP(bf16, WS_WGLU), 0)) return;
    if (tr_family(r, d, in_ptr(I_WBA), 4, 512, 1024, WSP(bf16, WS_WBA), 0)) return;
    if (tr_family(r, d, in_ptr(I_WBS), 4, 512, 1024, WSP(bf16, WS_WBS), 0)) return;
    if (tr_family(r, d, in_ptr(I_WOUT), 4, 1024, 1024, WSP(bf16, WS_WOUT), 0)) return;
    if (tr_family(r, d, in_ptr(I_FGU), 2, 1024, 2 * 2816, WSP(bf16, WS_WGU), 2816)) return;
    if (tr_family(r, d, in_ptr(I_FDN), 2, 2816, 1024, WSP(bf16, WS_WDN), 0)) return;
    if (tr_family(r, d, in_ptr(I_MGU), 16, 1024, 2 * 3584, WSP(bf16, WS_MGU), 3584)) return;
    if (tr_family(r, d, in_ptr(I_MDN), 16, 3584, 1024, WSP(bf16, WS_MDN), 0)) return;
    if (tr_family(r, d, in_ptr(I_PPROJ), 4, 256, 1024, WSP(bf16, WS_PPJ), 0)) return;
    tr_family(r, d, in_ptr(I_PGATE), 4, 1024, 1024, WSP(bf16, WS_PGT), 0);
}
__device__ __forceinline__ void tr_load(float (&v)[32], const TrItem& d, int lane) {
    const float* p = d.src + (size_t)(lane >> 5) * d.N + (lane & 31);
#pragma unroll
    for (int i = 0; i < 32; ++i) v[i] = *(const GAS float*)(p + (size_t)(2 * i) * d.N);
}
__device__ __forceinline__ void tr_store(const float (&v)[32], const TrItem& d, LAS float* scr, int lane) {
#pragma unroll
    for (int i = 0; i < 32; ++i) scr[(2 * i + (lane >> 5)) * 33 + (lane & 31)] = v[i];
    LDS_WAIT(); asm volatile("" ::: "memory");
    const int c = lane & 7;
#pragma unroll
    for (int j = 0; j < 4; ++j) { const int n = (lane >> 3) + 8 * j; const LAS float* s = scr + (8 * c) * 33 + n;
        v4u o; o.x = pk2(s[0 * 33], s[1 * 33]); o.y = pk2(s[2 * 33], s[3 * 33]); o.z = pk2(s[4 * 33], s[5 * 33]); o.w = pk2(s[6 * 33], s[7 * 33]);
        *(GAS v4u*)(d.dst + (size_t)n * d.K + 8 * c) = o; }
    LDS_WAIT(); asm volatile("" ::: "memory");
}

__device__ __forceinline__ void ssm_build(LAS unsigned char* lds, int l, int g, int tid) {
    unsigned char* ws = ws_ptr();
    LAS f32x2* lamd = (LAS f32x2*)lds;
    LAS f32x2* bbar = lamd + 17 * 64;
    LAS f32x2* cc = bbar + 64 * 16;
    LAS float* Kt = (LAS float*)(cc + 16 * 64);
    const int lg = l * 32 + g;
    if (tid < 64) {
        const int p = tid; const double lr = in_ptr(I_LRE)[lg * 64 + p], li = in_ptr(I_LIM)[lg * 64 + p], dt = exp((double)in_ptr(I_LOGDT)[lg]);
        for (int d = 0; d <= 16; ++d) { const double mag = exp(d * lr * dt), ang = d * li * dt; lamd[d * 64 + p] = (f32x2){(float)(mag * cos(ang)), (float)(mag * sin(ang))}; }
        const double m1 = exp(lr * dt), br = m1 * cos(li * dt) - 1.0, bi = m1 * sin(li * dt), den = lr * lr + li * li;
        const double cr = (br * lr + bi * li) / den, ci = (bi * lr - br * li) / den;
        for (int h = 0; h < 16; ++h) { const double xr = in_ptr(I_BRE)[(lg * 64 + p) * 16 + h], xi = in_ptr(I_BIM)[(lg * 64 + p) * 16 + h];
            bbar[p * 16 + h] = (f32x2){(float)(cr * xr - ci * xi), (float)(cr * xi + ci * xr)}; }
        const double mL = exp(16 * lr * dt), aL = 16 * li * dt;
        ((f32x2*)(ws + WS_MISC))[lg * 64 + p] = (f32x2){(float)(mL * cos(aL)), (float)(mL * sin(aL))};
    }
    for (int i = tid; i < 1024; i += 512) { const int h = i >> 6, p = i & 63; cc[i] = (f32x2){in_ptr(I_CRE)[(lg * 16 + h) * 64 + p], in_ptr(I_CIM)[(lg * 16 + h) * 64 + p]}; }
    __syncthreads();
    for (int o = tid; o < 4096; o += 512) { const int d = o >> 8, h = (o >> 4) & 15, h2 = o & 15; float s = 0.f;
        for (int p = 0; p < 64; ++p) { const f32x2 c = cc[h * 64 + p], lm = lamd[d * 64 + p], b = bbar[p * 16 + h2];
            const float tr = c.x * lm.x - c.y * lm.y, ti = c.x * lm.y + c.y * lm.x; s += tr * b.x - ti * b.y; }
        Kt[o] = s; }
    __syncthreads();
    bf16* SG = (bf16*)(ws + WS_SG) + (size_t)lg * 256 * 256;
    for (int ck = tid; ck < 256 * 32; ck += 512) { const int n = ck >> 5, k0 = (ck & 31) * 8, i = k0 >> 4, h0 = k0 & 15; float v[8];
#pragma unroll
        for (int j = 0; j < 8; ++j) { if (n < 128) { const int p = n & 63; const f32x2 lm = lamd[(15 - i) * 64 + p], b = bbar[p * 16 + h0 + j];
                v[j] = n < 64 ? lm.x * b.x - lm.y * b.y : lm.x * b.y + lm.y * b.x; } else v[j] = 0.f; }
        v4u o; o.x = pk2(v[0], v[1]); o.y = pk2(v[2], v[3]); o.z = pk2(v[4], v[5]); o.w = pk2(v[6], v[7]);
        *(GAS v4u*)(SG + (size_t)n * 256 + k0) = o; }
    bf16* TZ = (bf16*)(ws + WS_TZE) + (size_t)lg * 256 * 384;
    for (int ck = tid; ck < 256 * 48; ck += 512) { const int n = ck / 48, k0 = (ck % 48) * 8, j = n >> 4, h = n & 15; float v[8];
#pragma unroll
        for (int q = 0; q < 8; ++q) { const int k = k0 + q;
            if (k < 256) { const int i = k >> 4, h2 = k & 15; v[q] = i <= j ? Kt[((j - i) * 16 + h) * 16 + h2] : 0.f; }
            else { const int p = (k - 256) & 63; const f32x2 c = cc[h * 64 + p], lm = lamd[(j + 1) * 64 + p];
                v[q] = k < 320 ? c.x * lm.x - c.y * lm.y : -(c.x * lm.y + c.y * lm.x); } }
        v4u o; o.x = pk2(v[0], v[1]); o.y = pk2(v[2], v[3]); o.z = pk2(v[4], v[5]); o.w = pk2(v[6], v[7]);
        *(GAS v4u*)(TZ + (size_t)n * 384 + k0) = o; }
    __syncthreads();
}

__device__ __forceinline__ void cvt_rows(const float* src, bf16* dst, size_t n8, size_t gtid, size_t gthreads) {
    for (size_t i0 = gtid; i0 < n8; i0 += 8 * gthreads) {
        f32x4 a[8], b[8];
#pragma unroll
        for (int u = 0; u < 8; ++u) { const size_t i = i0 + u * gthreads; if (i < n8) { a[u] = *(const GAS f32x4*)(src + i * 8); b[u] = *(const GAS f32x4*)(src + i * 8 + 4); } else { a[u] = (f32x4){0.f, 0.f, 0.f, 0.f}; b[u] = a[u]; } }
#pragma unroll
        for (int u = 0; u < 8; ++u) { const size_t i = i0 + u * gthreads; if (i < n8) { v4u o; o.x = pk2(a[u].x, a[u].y); o.y = pk2(a[u].z, a[u].w); o.z = pk2(b[u].x, b[u].y); o.w = pk2(b[u].z, b[u].w); *(GAS v4u*)(dst + i * 8) = o; } }
    }
}

constexpr int ATT_KS = 72, ATT_VS = 264;
constexpr int ATT_K_OFF = 0, ATT_V_OFF = 256 * ATT_KS * 2, ATT_B_OFF = ATT_V_OFF + 64 * ATT_VS * 2;
struct AttStage { v4u k[4], v0[2], v1[2]; float bias; };
__device__ __forceinline__ void attn_stage_load(AttStage& st, const bf16* KV, const float* RB, int b, int qb, int kvh, int tid) {
    const int s0 = qb * 128; const size_t tok0 = (size_t)b * SEQ + s0;
#pragma unroll
    for (int i = 0; i < 4; ++i) { const int id = tid + 512 * i, row = id >> 3, ch = id & 7; st.k[i] = (v4u){0u, 0u, 0u, 0u};
        if (s0 + row - 128 >= 0) st.k[i] = *(const GAS v4u*)(KV + (tok0 + row - 128) * 256 + kvh * 64 + ch * 8); }
#pragma unroll
    for (int i = 0; i < 2; ++i) { const int id = tid + 512 * i, kp = id & 127, ch = id >> 7; st.v0[i] = (v4u){0u, 0u, 0u, 0u}; st.v1[i] = st.v0[i];
        if (s0 + 2 * kp - 128 >= 0) { st.v0[i] = *(const GAS v4u*)(KV + (tok0 + 2 * kp - 128) * 256 + 128 + kvh * 64 + ch * 8); st.v1[i] = *(const GAS v4u*)(KV + (tok0 + 2 * kp + 1 - 128) * 256 + 128 + kvh * 64 + ch * 8); } }
    st.bias = RB[(kvh * 4 + (tid >> 7)) * 128 + (tid & 127)];
}
__device__ __forceinline__ void attn_unit(LAS unsigned char* lds, AttStage& st, const bf16* Q, const bf16* KV, bf16* AO, const float* RB, const float* sinks, int b, int qb, int kvh, bool has_next, int nb, int nqb, int nkvh, int tid) {
    const int lane = tid & 63, wid = __builtin_amdgcn_readfirstlane(tid >> 6), fr = lane & 15, fq = lane >> 4;
    const int s0 = qb * 128; const size_t tok0 = (size_t)b * SEQ + s0;
    LAS bf16* Ks = (LAS bf16*)(lds + ATT_K_OFF); LAS bf16* Vt = (LAS bf16*)(lds + ATT_V_OFF); LAS float* Bl = (LAS float*)(lds + ATT_B_OFF);
#pragma unroll
    for (int i = 0; i < 4; ++i) { const int id = tid + 512 * i, row = id >> 3, ch = id & 7; *(LAS v4u*)(Ks + row * ATT_KS + ch * 8) = st.k[i]; }
#pragma unroll
    for (int i = 0; i < 2; ++i) { const int id = tid + 512 * i, kp = id & 127, ch = id >> 7;
        const unsigned a0[4] = {st.v0[i].x, st.v0[i].y, st.v0[i].z, st.v0[i].w}, a1[4] = {st.v1[i].x, st.v1[i].y, st.v1[i].z, st.v1[i].w};
#pragma unroll
        for (int j = 0; j < 4; ++j) { const unsigned lo = (a0[j] & 0xffffu) | (a1[j] << 16), hi = (a0[j] >> 16) | (a1[j] & 0xffff0000u);
            *(LAS unsigned*)(Vt + (ch * 8 + 2 * j) * ATT_VS + 2 * kp) = lo; *(LAS unsigned*)(Vt + (ch * 8 + 2 * j + 1) * ATT_VS + 2 * kp) = hi; } }
    { const int hh = tid >> 7, d = tid & 127; Bl[hh * 176 + 16 + d] = st.bias; }
    LDS_WAIT(); __syncthreads();
    if (has_next) attn_stage_load(st, KV, RB, nb, nqb, nkvh, tid);
    const int hh = wid >> 1, head = kvh * 4 + hh; const float sink2 = sinks[head] * LOG2E;
    const LAS float* blp = Bl + hh * 176 + 16 + 128 + fr - 4 * fq;
#pragma unroll 1
    for (int it = 0; it < 4; ++it) {
        const int q0 = 64 * (wid & 1) + 16 * it, kt0 = q0 >> 4;
        const bf16* qp = Q + (tok0 + q0 + fr) * 512 + head * 64 + 8 * fq;
        const bf16x8 qf0 = *(const GAS bf16x8*)qp, qf1 = *(const GAS bf16x8*)(qp + 32);
        const float zz = pg8::opaque_f(0.f); const f32x4 zero4 = (f32x4){zz, zz, zz, zz};
        f32x4 st[9]; float mx = -3.0e38f;
#pragma unroll
        for (int t = 0; t < 9; ++t) {
            const LAS bf16* kp = Ks + (16 * (kt0 + t) + fr) * ATT_KS + 8 * fq;
            const bf16x8 k0 = *(const LAS bf16x8*)kp, k1 = *(const LAS bf16x8*)(kp + 32);
            f32x4 s = __builtin_amdgcn_mfma_f32_16x16x32_bf16(k0, qf0, zero4, 0, 0, 0);
            s = __builtin_amdgcn_mfma_f32_16x16x32_bf16(k1, qf1, s, 0, 0, 0);
            const bool tile_ok = (s0 + 16 * (kt0 + t) - 128 >= 0);
#pragma unroll
            for (int r = 0; r < 4; ++r) { const int dist = 128 + fr - 4 * fq - 16 * t - r; const float bv = blp[-16 * t - r];
                const bool ok = tile_ok && dist >= 0 && dist < 128; s[r] = ok ? s[r] + bv : -3.0e38f; mx = fmaxf(mx, s[r]); }
            st[t] = s;
        }
        mx = fmaxf(mx, pg8::shx(mx, 16, lane)); mx = fmaxf(mx, pg8::shx(mx, 32, lane)); mx = fmaxf(mx, sink2);
        float sum = 0.f;
#pragma unroll
        for (int t = 0; t < 9; ++t)
#pragma unroll
            for (int r = 0; r < 4; ++r) { const float p = __builtin_amdgcn_exp2f(st[t][r] - mx); st[t][r] = p; sum += p; }
        sum += pg8::shx(sum, 16, lane); sum += pg8::shx(sum, 32, lane);
        const float inv = 1.0f / (sum + __builtin_amdgcn_exp2f(sink2 - mx));
        f32x4 ot[4];
#pragma unroll
        for (int dt = 0; dt < 4; ++dt) ot[dt] = zero4;
#pragma unroll
        for (int k = 0; k < 5; ++k) {
            v4u pw; pw.x = pg8::cvt_pk_bf16(st[2 * k][0], st[2 * k][1]); pw.y = pg8::cvt_pk_bf16(st[2 * k][2], st[2 * k][3]);
            if (k < 4) { pw.z = pg8::cvt_pk_bf16(st[2 * k + 1][0], st[2 * k + 1][1]); pw.w = pg8::cvt_pk_bf16(st[2 * k + 1][2], st[2 * k + 1][3]); } else { pw.z = 0u; pw.w = 0u; }
            const bf16x8 pb = __builtin_bit_cast(bf16x8, pw);
#pragma unroll
            for (int dt = 0; dt < 4; ++dt) {
                const LAS bf16* vp = Vt + (16 * dt + fr) * ATT_VS + 16 * (kt0 + 2 * k) + 4 * fq;
                const v2u a = *(const LAS v2u*)vp; v2u c = (v2u){0u, 0u}; if (k < 4) c = *(const LAS v2u*)(vp + 16);
                const v4u av = (v4u){a.x, a.y, c.x, c.y};
                ot[dt] = __builtin_amdgcn_mfma_f32_16x16x32_bf16(__builtin_bit_cast(bf16x8, av), pb, ot[dt], 0, 0, 0);
            }
        }
        bf16* op = AO + (tok0 + q0 + fr) * 512 + head * 64 + 4 * fq;
#pragma unroll
        for (int dt = 0; dt < 4; ++dt) { v2u w; w.x = pg8::cvt_pk_bf16(ot[dt][0] * inv, ot[dt][1] * inv); w.y = pg8::cvt_pk_bf16(ot[dt][2] * inv, ot[dt][3] * inv); *(GAS v2u*)(op + 16 * dt) = w; }
    }
    __syncthreads();
}

__device__ __forceinline__ void scan_chain(const float* SL, bf16* UG, f32x2 aL, int g, int b, int lane) {
    const size_t row0 = (size_t)g * 2048 + b * 128;
    float xr = 0.f, xi = 0.f;
    float cr[8], ci[8], nr[8], ni[8];
#pragma unroll
    for (int k = 0; k < 8; ++k) { cr[k] = SL[(row0 + k) * 128 + lane]; ci[k] = SL[(row0 + k) * 128 + 64 + lane]; }
#pragma unroll 1
    for (int c0 = 0; c0 < NCHUNK; c0 += 8) {
        if (c0 + 8 < NCHUNK) {
#pragma unroll
            for (int k = 0; k < 8; ++k) { nr[k] = SL[(row0 + c0 + 8 + k) * 128 + lane]; ni[k] = SL[(row0 + c0 + 8 + k) * 128 + 64 + lane]; }
        }
#pragma unroll
        for (int k = 0; k < 8; ++k) {
            bf16* up = UG + (row0 + c0 + k) * UGLD + 256;
            up[lane] = (bf16)f2bf(xr); up[64 + lane] = (bf16)f2bf(xi);
            const float tr = aL.x * xr - aL.y * xi + cr[k], ti = aL.x * xi + aL.y * xr + ci[k]; xr = tr; xi = ti;
        }
#pragma unroll
        for (int k = 0; k < 8; ++k) { cr[k] = nr[k]; ci[k] = ni[k]; }
    }
}

struct RowRaw { v2u w[4]; };
__device__ __forceinline__ void row_load(RowRaw& r, const bf16* p, int lane) {
#pragma unroll
    for (int j = 0; j < 4; ++j) r.w[j] = *(const GAS v2u*)(p + 256 * j + 4 * lane);
}
__device__ __forceinline__ void row_unpack(f32x4 (&v)[4], const RowRaw& r) {
#pragma unroll
    for (int j = 0; j < 4; ++j) v[j] = (f32x4){pg8::bf_lo(r.w[j].x), pg8::bf_hi(r.w[j].x), pg8::bf_lo(r.w[j].y), pg8::bf_hi(r.w[j].y)};
}
__device__ __forceinline__ void route_row(const f32x4 (&v)[4], const LAS float* rt, int lane, int& e1, int& e2, float& g1, float& g2) {
    float s[8];
#pragma unroll
    for (int e = 0; e < 8; ++e) { float a = 0.f;
#pragma unroll
        for (int j = 0; j < 4; ++j) { const f32x4 w = *(const LAS f32x4*)(rt + e * DM + 256 * j + 4 * lane); a += (v[j].x * w.x + v[j].y * w.y) + (v[j].z * w.z + v[j].w * w.w); }
        s[e] = a; }
    const bool b5 = (lane & 32) != 0, b4 = (lane & 16) != 0, b3 = (lane & 8) != 0;
    float r[4], q[2];
#pragma unroll
    for (int i = 0; i < 4; ++i) { const float mine = b5 ? s[i + 4] : s[i], other = b5 ? s[i] : s[i + 4]; r[i] = mine + pg8::shx(other, 32, lane); }
#pragma unroll
    for (int i = 0; i < 2; ++i) { const float mine = b4 ? r[i + 2] : r[i], other = b4 ? r[i] : r[i + 2]; q[i] = mine + pg8::shx(other, 16, lane); }
    float w = (b3 ? q[1] : q[0]) + pg8::shx(b3 ? q[0] : q[1], 8, lane);
    w += pg8::shx(w, 4, lane); w += pg8::shx(w, 2, lane); w += pg8::shx(w, 1, lane);
    float lg[8];
#pragma unroll
    for (int e = 0; e < 8; ++e) lg[e] = __uint_as_float((unsigned)__builtin_amdgcn_readlane((int)__float_as_uint(w), 8 * e));
    e1 = 0; float v1 = lg[0];
#pragma unroll
    for (int e = 1; e < 8; ++e) if (lg[e] > v1) { v1 = lg[e]; e1 = e; }
    e2 = -1; float v2 = -3.0e38f;
#pragma unroll
    for (int e = 0; e < 8; ++e) if (e != e1 && lg[e] > v2) { v2 = lg[e]; e2 = e; }
    g1 = 1.0f / (1.0f + __expf(v2 - v1)); g2 = 1.0f - g1;
}
__device__ __forceinline__ void ln_load_bf16(f32x4 (&v)[4], const bf16* hrow, int lane) {
#pragma unroll
    for (int j = 0; j < 4; ++j) { const v2u w = *(const GAS v2u*)(hrow + 256 * j + 4 * lane); v[j] = (f32x4){pg8::bf_lo(w.x), pg8::bf_hi(w.x), pg8::bf_lo(w.y), pg8::bf_hi(w.y)}; }
}
__device__ __forceinline__ void ln_finish(f32x4 (&v)[4], const float* gam, const float* bet, float* outrow, bf16* xbrow, int lane) {
    float s = 0.f;
#pragma unroll
    for (int j = 0; j < 4; ++j) s += (v[j].x + v[j].y) + (v[j].z + v[j].w);
    const float mean = wave_sum(s, lane) * (1.f / DM); float s2 = 0.f;
#pragma unroll
    for (int j = 0; j < 4; ++j) { v[j] = v[j] - mean; s2 += (v[j].x * v[j].x + v[j].y * v[j].y) + (v[j].z * v[j].z + v[j].w * v[j].w); }
    const float rstd = 1.f / sqrtf(wave_sum(s2, lane) * (1.f / DM) + LN_EPS);
#pragma unroll
    for (int j = 0; j < 4; ++j) { const f32x4 gg = *(const GAS f32x4*)(gam + 256 * j + 4 * lane), bb = *(const GAS f32x4*)(bet + 256 * j + 4 * lane);
        v[j] = v[j] * rstd * gg + bb;
        if (outrow) *(GAS f32x4*)(outrow + 256 * j + 4 * lane) = v[j];
        v2u w; w.x = pk2(v[j].x, v[j].y); w.y = pk2(v[j].z, v[j].w); *(GAS v2u*)(xbrow + 256 * j + 4 * lane) = w; }
}

constexpr int NPH = 11;
__global__ void __launch_bounds__(NWAVES * 64, 2) fwd(Args args) {
    extern __shared__ __attribute__((aligned(16))) unsigned char lds_raw[];
    LAS unsigned char* lds = (LAS unsigned char*)lds_raw;
    volatile LAS unsigned* MISC = (volatile LAS unsigned*)(lds + MISC_OFF);
    const int G = gridDim.x, wave0 = __builtin_amdgcn_readfirstlane(threadIdx.x >> 6);
    { const int tid = threadIdx.x;
#define ctl WSP(unsigned, WS_CTL)
    for (int u = tid; u < (LDS_BYTES - LDSCTL_OFF) / 4; u += NWAVES * 64) ((LAS unsigned*)(lds + LDSCTL_OFF))[u] = 0u; }
    __syncthreads();
    XcdBarrier bar; bar.bar = (unsigned*)ctl + CW_BAR; bar.x = 0; bar.st = nullptr;
    if (!MK_PER_PHASE) bar = xcd_barrier_post((unsigned*)ctl + CW_BAR, MISC + 8, wave0 * 64 + pg8::lane_id());
    const int lo = args.ph_lo, hi = args.ph_hi;
#define IN(k) (lo <= (k) && (k) < hi)
#define SEAM(k) do { if (!MK_PER_PHASE && IN((k) + 1)) xcd_barrier(bar, wave0 * 64 + pg8::lane_id()); } while (0)
#define PHASE_IDS const int lane = pg8::lane_id(), wave = wave0, tid = wave * 64 + lane, bx = pg8::opaque_s(blockIdx.x), gw = bx * NWAVES + wave, NGW = G * NWAVES; (void)lane; (void)gw; (void)NGW

#define WIN WSP(bf16, WS_WIN)
#define WGLU WSP(bf16, WS_WGLU)
#define WBA WSP(bf16, WS_WBA)
#define WBS WSP(bf16, WS_WBS)
#define WOUT WSP(bf16, WS_WOUT)
#define WGU WSP(bf16, WS_WGU)
#define WDN WSP(bf16, WS_WDN)
#define MGU WSP(bf16, WS_MGU)
#define MDN WSP(bf16, WS_MDN)
#define PPJ WSP(bf16, WS_PPJ)
#define PGT WSP(bf16, WS_PGT)
#define SGm WSP(bf16, WS_SG)
#define TZE WSP(bf16, WS_TZE)
#define LAML WSP(f32x2, WS_MISC)
#define RB WSP(float, WS_MISC + 65536)
#define TOKE WSP(int, WS_MISC + 131072)
#define TOKG WSP(float, WS_MISC + 393216)
#define TOKP WSP(int, WS_MISC + 655360)
#define PB WSP(bf16, WS_PB)
#define XB WSP(bf16, WS_XB)
#define PP WSP(bf16, WS_PP)
#define XS WSP(bf16, WS_XS)
#define XIDX WSP(int, WS_XS + 256 * MiB)
#define Qb WSP(bf16, WS_Q)
#define KVb WSP(bf16, WS_KV)
#define UG WSP(bf16, WS_UG)
#define GAb WSP(bf16, WS_GA)
#define GSb WSP(bf16, WS_GS)
#define SL WSP(float, WS_SL)
#define AO WSP(bf16, WS_AO)
#define YB WSP(bf16, WS_YB)
#define SO WSP(bf16, WS_SO)
#define T1 WSP(bf16, WS_T1)
#define MG WSP(bf16, WS_MG)
#define HB WSP(bf16, WS_HB)
#define HBUF WSP(bf16, WS_HBUF)
#define R out_ptr()

    if (IN(0)) {
        PHASE_IDS; const size_t gtid = (size_t)bx * 512 + tid, gthreads = (size_t)G * 512;
        LAS float* scr = (LAS float*)(lds + RING_OFF + wave * 16384);
        for (int task = bx; task < DEPTH * 32; task += G) ssm_build(lds, task >> 5, task & 31, tid);
        if (bx == G - 1) { for (int i = tid; i < 8 * 128; i += 512) { const int h = i >> 7, d = i & 127; int bk = d;
                if (d >= 16) { bk = 16 + (int)(log((double)d / 16.0) / log(8.0) * 16.0); bk = bk > 31 ? 31 : bk; }
                RB[i] = in_ptr(I_RELB)[bk * 8 + h] * LOG2E; } }
        __syncthreads();
        {
            TrItem d0 = {nullptr, nullptr, 0, 0}; float r0[32];
#pragma unroll
            for (int i = 0; i < 32; ++i) r0[i] = 0.f;
            if (gw < TR_NIT) { tr_desc(d0, gw); tr_load(r0, d0, lane); }
#pragma unroll 1
            for (int it = gw; it < TR_NIT; it += NGW) {
                TrItem d1 = d0; float r1[32];
#pragma unroll
                for (int i = 0; i < 32; ++i) r1[i] = r0[i];
                if (it + NGW < TR_NIT) { tr_desc(d1, it + NGW); tr_load(r1, d1, lane); }
                tr_store(r0, d0, scr, lane);
                d0 = d1;
#pragma unroll
                for (int i = 0; i < 32; ++i) r0[i] = r1[i];
            }
        }
        cvt_rows(in_ptr(I_P), PB, (size_t)DEPTH * T * PLE / 8, gtid, gthreads);
        cvt_rows(in_ptr(I_X), XB, (size_t)T * DM / 8, gtid, gthreads);
        SEAM(0);
    }

#pragma unroll 1
    for (int l = 0; l < DEPTH; ++l) {
        const int P0 = 1 + l * NPH;
        const bool moe = (l & 1) != 0; const int l2 = l >> 1;
        if (IN(P0 + 0)) {
            PHASE_IDS;
            pg8::Gemm g{XB, WIN + (size_t)l * IN_COLS * 1024, 1024, 1024, 1024}; pg8::StaticOrder S; S.init(T, IN_COLS, G, bx);
            pg8::EpiInProj E{Qb, KVb, UG, GAb, GSb};
            pg8::gemm_phase<pg8::EpiInProj, pg8::StaticOrder, true, true>(lds + RING_OFF, g, S, E, tid);
            { pg8::Gemm g2{PB + (size_t)l * T * PLE, PPJ + (size_t)l * 1024 * PLE, PLE, PLE, pg8::opaque_s(PLE)}; pg8::StaticOrder S2; pg8::init_short(S2, T, 1024, G, bx, ((T / 256) * (IN_COLS / 256)) % G);
              pg8::EpiEw<0> E2{PP, 1024, nullptr, nullptr, nullptr};
              pg8::gemm_phase<pg8::EpiEw<0>, pg8::StaticOrder, true, true>(lds + RING_OFF, g2, S2, E2, tid); }
            SEAM(P0 + 0);
        }
        if (IN(P0 + 1)) {
            PHASE_IDS;
            { pg8::Gemm g{UG, SGm + (size_t)l * 32 * 256 * 256, UGLD, 256, 256}; pg8::GroupOrder S; S.init(UGROWS / 256, 3, G, bx);
              pg8::EpiS E{SL};
              pg8::gemm_phase<pg8::EpiS, pg8::GroupOrder, true, true>(lds + RING_OFF, g, S, E, tid); }
            SEAM(P0 + 1);
        }
        if (IN(P0 + 2)) {
            PHASE_IDS;
            if (wave < 2) { for (int ch = bx * 2 + wave; ch < 32 * BATCH; ch += 2 * G) { const int g = ch >> 4, b = ch & 15; scan_chain(SL, UG, LAML[(l * 32 + g) * 64 + lane], g, b, lane); } }
            { AttStage st = {}; const int NU = BATCH * 16 * 2;
              if (bx < NU) attn_stage_load(st, KVb, RB, bx >> 5, (bx >> 1) & 15, bx & 1, tid);
              for (int un = bx; un < NU; un += G) { const int kvh = un & 1, qb = (un >> 1) & 15, b = un >> 5, nu = un + G; const bool hn = nu < NU;
                attn_unit(lds + RING_OFF, st, Qb, KVb, AO, RB, in_ptr(I_SINKS) + l * 8, b, qb, kvh, hn, nu >> 5, (nu >> 1) & 15, nu & 1, tid); } }
            SEAM(P0 + 2);
        }
        if (IN(P0 + 3)) {
            PHASE_IDS;
            pg8::Gemm g{UG, TZE + (size_t)l * 32 * 256 * 384, UGLD, 384, 384}; pg8::GroupOrder S; S.init(UGROWS / 256, 3, G, bx);
            pg8::EpiY E{UG, in_ptr(I_SSMD) + l * 512, YB};
            pg8::gemm_phase<pg8::EpiY, pg8::GroupOrder, true, true>(lds + RING_OFF, g, S, E, tid);
            SEAM(P0 + 3);
        }
        if (IN(P0 + 4)) {
            PHASE_IDS;
            { pg8::Gemm g{YB, WGLU + (size_t)l * 512 * 512, 512, 512, 512}; pg8::StaticOrder S; S.init(T, 512, G, bx);
              pg8::EpiEw<1> E{SO, 512, YB, nullptr, in_ptr(I_BGLU) + l * 512};
              pg8::gemm_phase<pg8::EpiEw<1>, pg8::StaticOrder, true, true>(lds + RING_OFF, g, S, E, tid); }
            { pg8::Gemm g{AO, WBA + (size_t)l * 1024 * 512, 512, 512, 512}; pg8::StaticOrder S; S.init(T, 1024, G, bx);
              pg8::EpiEw<2> E{T1, 1024, GAb, nullptr, nullptr};
              pg8::gemm_phase<pg8::EpiEw<2>, pg8::StaticOrder, true, true>(lds + RING_OFF, g, S, E, tid); }
            SEAM(P0 + 4);
        }
        if (IN(P0 + 5)) {
            PHASE_IDS;
            pg8::Gemm g{SO, WBS + (size_t)l * 1024 * 512, 512, 512, 512}; pg8::StaticOrder S; S.init(T, 1024, G, bx);
            pg8::EpiEw<3> E{MG, 1024, GSb, T1, nullptr};
            pg8::gemm_phase<pg8::EpiEw<3>, pg8::StaticOrder, true, true>(lds + RING_OFF, g, S, E, tid);
            SEAM(P0 + 5);
        }
        if (IN(P0 + 6)) {
            PHASE_IDS;
            pg8::Gemm g{MG, WOUT + (size_t)l * 1024 * 1024, 1024, 1024, 1024}; pg8::StaticOrder S; S.init(T, 1024, G, bx);
            pg8::EpiEw<5> E{HBUF, 1024, XB, nullptr, nullptr};
            pg8::gemm_phase<pg8::EpiEw<5>, pg8::StaticOrder, true, true>(lds + RING_OFF, g, S, E, tid);
            SEAM(P0 + 6);
        }
        if (IN(P0 + 7)) {
            PHASE_IDS;
            const float* gam = in_ptr(I_LN1G) + l * DM; const float* bet = in_ptr(I_LN1B) + l * DM;
            LAS float* rt = (LAS float*)(lds + RING_OFF);
            if (moe) { const float* rw = in_ptr(I_ROUTER) + (size_t)l2 * DM * NEXP; for (int i = tid; i < DM * NEXP; i += 512) rt[(i & 7) * DM + (i >> 3)] = rw[i]; LDS_WAIT(); __syncthreads(); }
            unsigned* cur = (unsigned*)ctl + CW_MOE + (l2 * 16 + 8) * 64;
            for (int base = gw * 16; base < T; base += NGW * 16) {
                int ev = -1;
                RowRaw ca, cb; row_load(ca, HBUF + (size_t)base * DM, lane); row_load(cb, HBUF + (size_t)(base + 1) * DM, lane);
#pragma unroll 1
                for (int k = 0; k < 16; k += 2) { const int row = base + k;
                    RowRaw na = ca, nb = cb;
                    if (k + 2 < 16) { row_load(na, HBUF + (size_t)(row + 2) * DM, lane); row_load(nb, HBUF + (size_t)(row + 3) * DM, lane); }
                    f32x4 va[4], vb[4]; row_unpack(va, ca); row_unpack(vb, cb);
                    ln_finish(va, gam, bet, nullptr, XB + (size_t)row * DM, lane);
                    ln_finish(vb, gam, bet, nullptr, XB + (size_t)(row + 1) * DM, lane);
                    if (moe) {
                        int a1, a2, b1, b2; float ga1, ga2, gb1, gb2;
                        route_row(va, rt, lane, a1, a2, ga1, ga2); route_row(vb, rt, lane, b1, b2, gb1, gb2);
                        if (lane == 0) { TOKE[row * 2] = a1; TOKE[row * 2 + 1] = a2; TOKG[row * 2] = ga1; TOKG[row * 2 + 1] = ga2; TOKE[row * 2 + 2] = b1; TOKE[row * 2 + 3] = b2; TOKG[row * 2 + 2] = gb1; TOKG[row * 2 + 3] = gb2; }
                        if (lane == 2 * k) ev = a1; if (lane == 2 * k + 1) ev = a2; if (lane == 2 * k + 2) ev = b1; if (lane == 2 * k + 3) ev = b2;
                    }
                    ca = na; cb = nb;
                }
                if (moe) {
                    int rank = 0, mycnt = 0;
#pragma unroll
                    for (int x = 0; x < 8; ++x) { const unsigned long long mask = __ballot(ev == x); if (ev == x) rank = __popcll(mask & ((1ull << lane) - 1ull)); if (lane == x) mycnt = __popcll(mask); }
                    int old = 0; if (lane < 8 && mycnt) old = (int)xb_add(cur + lane * 64, (unsigned)mycnt);
                    const int pos = __builtin_amdgcn_ds_bpermute((ev < 0 ? 0 : ev) << 2, old) + rank;
                    if (lane < 32) { TOKP[base * 2 + lane] = pos; XIDX[(size_t)ev * T + pos] = base + (lane >> 1); }
                }
            }
            __syncthreads();
            SEAM(P0 + 7);
        }
        int tb1 = 0, tb2 = 0, tb3 = 0, tb4 = 0, tb5 = 0, tb6 = 0, tb7 = 0, NT = 0;
        if (moe && hi > P0 + 7) { unsigned* cw = (unsigned*)ctl + CW_MOE + (l2 * 16 + 8) * 64; int t = 0;
            t += ((int)xb_ld(cw + 0 * 64) + 255) >> 8; tb1 = t; t += ((int)xb_ld(cw + 1 * 64) + 255) >> 8; tb2 = t; t += ((int)xb_ld(cw + 2 * 64) + 255) >> 8; tb3 = t;
            t += ((int)xb_ld(cw + 3 * 64) + 255) >> 8; tb4 = t; t += ((int)xb_ld(cw + 4 * 64) + 255) >> 8; tb5 = t; t += ((int)xb_ld(cw + 5 * 64) + 255) >> 8; tb6 = t;
            t += ((int)xb_ld(cw + 6 * 64) + 255) >> 8; tb7 = t; t += ((int)xb_ld(cw + 7 * 64) + 255) >> 8; NT = t;
            tb1 = __builtin_amdgcn_readfirstlane(tb1); tb2 = __builtin_amdgcn_readfirstlane(tb2); tb3 = __builtin_amdgcn_readfirstlane(tb3); tb4 = __builtin_amdgcn_readfirstlane(tb4);
            tb5 = __builtin_amdgcn_readfirstlane(tb5); tb6 = __builtin_amdgcn_readfirstlane(tb6); tb7 = __builtin_amdgcn_readfirstlane(tb7); NT = __builtin_amdgcn_readfirstlane(NT); }
        if (IN(P0 + 8)) {
            PHASE_IDS;
            if (!moe) { pg8::Gemm g{XB, WGU + (size_t)l2 * 2 * DFF * 1024, 1024, 1024, 1024}; pg8::StaticOrder S; S.init(T, 2 * DFF, G, bx);
                pg8::EpiSwiGLU E{HB, DFF};
                pg8::gemm_phase<pg8::EpiSwiGLU, pg8::StaticOrder, true, true>(lds + RING_OFF, g, S, E, tid);
                { pg8::Gemm g2{XB, PGT + (size_t)l * 1024 * 1024, 1024, 1024, 1024}; pg8::StaticOrder S2; S2.init(T, 1024, G, bx);
                  pg8::EpiEw<4> E2{PP, 1024, nullptr, nullptr, nullptr};
                  pg8::gemm_phase<pg8::EpiEw<4>, pg8::StaticOrder, true, true>(lds + RING_OFF, g2, S2, E2, tid); } }
            else { pg8::Gemm g{XB, MGU + (size_t)l2 * NEXP * 2 * DFFE * 1024, 1024, 1024, 1024};
                pg8::MoeOrder S{NT, 2 * DFFE / 256, NT * (2 * DFFE / 256), G, bx, T / 256, tb1, tb2, tb3, tb4, tb5, tb6, tb7};
                pg8::EpiSwiGLU E{HB, DFFE};
                pg8::gemm_phase<pg8::EpiSwiGLU, pg8::MoeOrder, true, true, true>(lds + RING_OFF, g, S, E, tid, XIDX, T - 1); }
            SEAM(P0 + 8);
        }
        if (IN(P0 + 9)) {
            PHASE_IDS;
            if (!moe) { pg8::Gemm g{HB, WDN + (size_t)l2 * 1024 * DFF, DFF, DFF, DFF}; pg8::StaticOrder S; S.init(T, 1024, G, bx);
                pg8::EpiEw<6> E{HBUF, 1024, XB, PP, nullptr};
                pg8::gemm_phase<pg8::EpiEw<6>, pg8::StaticOrder, true, true>(lds + RING_OFF, g, S, E, tid); }
            else { pg8::Gemm g{HB, MDN + (size_t)l2 * NEXP * 1024 * DFFE, DFFE, DFFE, DFFE};
                pg8::MoeOrder S{NT, 4, NT * 4, G, bx, 0, tb1, tb2, tb3, tb4, tb5, tb6, tb7};
                pg8::EpiEw<0> E{XS, 1024, nullptr, nullptr, nullptr};
                pg8::gemm_phase<pg8::EpiEw<0>, pg8::MoeOrder, true, true>(lds + RING_OFF, g, S, E, tid);
                { pg8::Gemm g2{XB, PGT + (size_t)l * 1024 * 1024, 1024, 1024, 1024}; pg8::StaticOrder S2; pg8::init_short(S2, T, 1024, G, bx, (NT * 4) % G);
                  pg8::EpiEw<4> E2{PP, 1024, nullptr, nullptr, nullptr};
                  pg8::gemm_phase<pg8::EpiEw<4>, pg8::StaticOrder, true, true>(lds + RING_OFF, g2, S2, E2, tid); } }
            SEAM(P0 + 9);
        }
        if (IN(P0 + 10)) {
            PHASE_IDS;
            const float* gam = in_ptr(I_LN2G) + l * DM; const float* bet = in_ptr(I_LN2B) + l * DM;
            for (int base = gw * 16; base < T; base += NGW * 16) {
                int tp = 0; float tg = 0.f;
                if (moe && lane < 32) { const int te = TOKE[base * 2 + lane]; tg = TOKG[base * 2 + lane];
                    tp = TOKP[base * 2 + lane] + 256 * (te == 0 ? 0 : te == 1 ? tb1 : te == 2 ? tb2 : te == 3 ? tb3 : te == 4 ? tb4 : te == 5 ? tb5 : te == 6 ? tb6 : tb7); }
                const bf16* xsrc = moe ? XB : HBUF;
                RowRaw cx[2] = {}, cy[2][2] = {}, cp[2] = {};
#define LN2_LOAD(dx, dy, dp, r0) do { _Pragma("unroll") for (int q_ = 0; q_ < 2; ++q_) { const int row_ = (r0) + q_; row_load(dx[q_], xsrc + (size_t)row_ * DM, lane); \
                    if (moe) { const int kk_ = row_ - base; const int p1_ = __builtin_amdgcn_readlane(tp, 2 * kk_), p2_ = __builtin_amdgcn_readlane(tp, 2 * kk_ + 1); \
                        row_load(dy[q_][0], XS + (size_t)p1_ * DM, lane); row_load(dy[q_][1], XS + (size_t)p2_ * DM, lane); row_load(dp[q_], PP + (size_t)row_ * DM, lane); } } } while (0)
                LN2_LOAD(cx, cy, cp, base);
#pragma unroll 1
                for (int k = 0; k < 16; k += 2) { const int row = base + k;
                    RowRaw nx[2], ny[2][2], np[2];
#pragma unroll
                    for (int q = 0; q < 2; ++q) { nx[q] = cx[q]; np[q] = cp[q]; ny[q][0] = cy[q][0]; ny[q][1] = cy[q][1]; }
                    if (k + 2 < 16) LN2_LOAD(nx, ny, np, row + 2);
#pragma unroll
                    for (int q = 0; q < 2; ++q) { f32x4 v[4]; row_unpack(v, cx[q]);
                        if (moe) { f32x4 fa[4], fb[4], fc[4]; row_unpack(fa, cy[q][0]); row_unpack(fb, cy[q][1]); row_unpack(fc, cp[q]);
                            const float g1 = __uint_as_float((unsigned)__builtin_amdgcn_readlane((int)__float_as_uint(tg), 2 * (k + q))), g2 = __uint_as_float((unsigned)__builtin_amdgcn_readlane((int)__float_as_uint(tg), 2 * (k + q) + 1));
#pragma unroll
                            for (int j = 0; j < 4; ++j) v[j] = v[j] * ALPHA + fa[j] * g1 + fb[j] * g2 + fc[j]; }
                        ln_finish(v, gam, bet, l + 1 < DEPTH ? nullptr : R + (size_t)(row + q) * DM, XB + (size_t)(row + q) * DM, lane); }
#pragma unroll
                    for (int q = 0; q < 2; ++q) { cx[q] = nx[q]; cp[q] = np[q]; cy[q][0] = ny[q][0]; cy[q][1] = ny[q][1]; }
                }
#undef LN2_LOAD
            }
            SEAM(P0 + 10);
        }
    }
#undef IN
#undef SEAM
}

extern "C" void kernel_launch(void* const* d_in, const int* in_sizes, int n_in, void* d_out, int out_size, void* d_ws, size_t ws_size, hipStream_t stream) {
    static int grid = 0;
    if (grid == 0) {
        if (n_in != 29 || out_size != T * DM || ws_size < WS_END) { fprintf(stderr, "kernel_launch: unexpected shapes (n_in %d, out %d, ws %zu, need %zu)\n", n_in, out_size, ws_size, (size_t)WS_END); grid = -1; return; }
        int dev = 0, cus = 0, per_cu = 0;
        if (hipGetDevice(&dev) != hipSuccess || hipDeviceGetAttribute(&cus, hipDeviceAttributeMultiprocessorCount, dev) != hipSuccess) { grid = -1; return; }
        if (hipFuncSetAttribute((const void*)fwd, hipFuncAttributeMaxDynamicSharedMemorySize, LDS_BYTES) != hipSuccess) { fprintf(stderr, "kernel_launch: hipFuncSetAttribute failed\n"); grid = -1; return; }
        if (hipOccupancyMaxActiveBlocksPerMultiprocessor(&per_cu, (const void*)fwd, NWAVES * 64, LDS_BYTES) != hipSuccess || per_cu < 1) fprintf(stderr, "kernel_launch: occupancy query reports %d\n", per_cu);
        (void)hipGetLastError();
        grid = cus;
    }
    if (grid < 0) return;
    if (hipMemsetAsync((char*)d_ws + WS_CTL, 0, CTL_ZERO_BYTES, stream) != hipSuccess) { fprintf(stderr, "kernel_launch: memset failed\n"); return; }
    Args a{};
    for (int i = 0; i < 29; ++i) a.in[i] = (const float*)d_in[i];
    a.out = (float*)d_out; a.ws = (unsigned char*)d_ws;
    const int NPHASES = 1 + DEPTH * NPH;
#if MK_PER_PHASE
    for (int ph = 0; ph < NPHASES; ++ph) { a.ph_lo = ph; a.ph_hi = ph + 1; hipLaunchKernelGGL(fwd, dim3(grid), dim3(NWAVES * 64), LDS_BYTES, stream, a); }
#else
    a.ph_lo = 0; a.ph_hi = NPHASES;
    hipLaunchKernelGGL(fwd, dim3(grid), dim3(NWAVES * 64), LDS_BYTES, stream, a);
#endif
    const hipError_t le = hipPeekAtLastError();
    if (le != hipSuccess) fprintf(stderr, "kernel_launch: launch failed: %s\n", hipGetErrorName(le));
}
```

```cpp
#include <hip/hip_runtime.h>
#include <cstdio>
#include <cstdint>

#ifndef MK_PER_PHASE
#define MK_PER_PHASE 0
#endif

namespace pg8 {
#define PG8_LAS __attribute__((address_space(3)))
typedef unsigned short bf16_t;
typedef short bf16x8 __attribute__((ext_vector_type(8)));
typedef float f32x4 __attribute__((ext_vector_type(4)));
typedef unsigned u32x4 __attribute__((ext_vector_type(4)));
typedef unsigned u32x2 __attribute__((ext_vector_type(2)));
__device__ __forceinline__ int opaque_v(int x) { asm volatile("" : "+v"(x)); return x; }
__device__ __forceinline__ int lane_id() { int l; asm volatile("v_mbcnt_lo_u32_b32 %0, -1, 0\n\tv_mbcnt_hi_u32_b32 %0, -1, %0" : "=v"(l)); return l; }
__device__ __forceinline__ float shx(float v, int o, int lane) { return __uint_as_float((unsigned)__builtin_amdgcn_ds_bpermute((lane ^ o) << 2, (int)__float_as_uint(v))); }
__device__ __forceinline__ float opaque_f(float x) { asm volatile("" : "+v"(x)); return x; }
__device__ __forceinline__ int opaque_s(int x) { asm volatile("" : "+s"(x)); return x; }
constexpr int BM = 256, BK = 64, HALF = 128, HTB = HALF * BK * 2, STAGE_BYTES = 8 * HTB, NXCD = 8, WGM = 8;

__host__ __device__ __forceinline__ int lds_byte(int r, int c) { const int st = (r >> 4) * 2 + (c >> 5), rr = r & 15, cc = c & 31, ob = rr * 64 + cc * 2; return st * 1024 + (ob ^ (((ob >> 9) & 1) << 5)); }
__host__ __device__ __forceinline__ void stage_rc(int b, int& R, int& C) { const int st = b / 1024, sb = b % 1024, swz = sb ^ (((sb >> 9) & 1) << 5); R = (st >> 1) * 16 + swz / 64; C = (st & 1) * 32 + (swz % 64) / 2; }
__host__ __device__ __forceinline__ int perm32(int rho) { const int n = rho >> 4, i = rho & 15; return 8 * (i >> 2) + 4 * n + (i & 3); }

struct Unit { int pm, pn, pc, pa; };
struct Gemm { const bf16_t* A; const bf16_t* Bt; int lda, ldb, K; };

struct StaticOrder {
    int nM, nN, nwg, G, c;
    __device__ void init(int M, int N, int G_, int c_) { nM = M / BM; nN = N / BM; nwg = nM * nN; G = G_; c = c_; }
    __device__ bool next(int i, Unit& u) const {
        const long L = (long)i * G + c; if (L >= nwg) return false;
        int wgid = (int)L; { const int q = nwg / NXCD, r = nwg % NXCD, xcd = wgid % NXCD, off = wgid / NXCD; wgid = (xcd < r ? xcd * (q + 1) : r * (q + 1) + (xcd - r) * q) + off; }
        const int nig = WGM * nN, gid = wgid / nig, fm = gid * WGM, gsz = (nM - fm) < WGM ? (nM - fm) : WGM;
        u.pm = fm + ((wgid % nig) % gsz); u.pn = (wgid % nig) / gsz; u.pc = u.pn; u.pa = u.pm; return true;
    }
    __device__ __forceinline__ void a_ready(const Unit&) const {}
    __device__ __forceinline__ void done(const Unit&) const {}
};
__device__ __forceinline__ void init_short(StaticOrder& S, int M, int N, int G, int c, int rem) {
    const int ns = rem == 0 ? G : G - rem; int cs = c - rem; if (cs < 0) cs += G;
    S.init(M, N, ns, cs < ns ? cs : (1 << 28));
}
struct GroupOrder {
    int nM, G, c, shift;
    __device__ void init(int nM_, int shift_, int G_, int c_) { nM = nM_; shift = shift_; G = G_; c = c_; }
    __device__ bool next(int i, Unit& u) const {
        const long L = (long)i * G + c; if (L >= nM) return false;
        int wgid = (int)L; { const int q = nM / NXCD, r = nM % NXCD, xcd = wgid % NXCD, off = wgid / NXCD; wgid = (xcd < r ? xcd * (q + 1) : r * (q + 1) + (xcd - r) * q) + off; }
        u.pm = wgid; u.pn = wgid >> shift; u.pc = 0; u.pa = wgid; return true;
    }
    __device__ __forceinline__ void a_ready(const Unit&) const {}
    __device__ __forceinline__ void done(const Unit&) const {}
};
struct MoeOrder {
    int nM, nN, nwg, G, c, acap, t1, t2, t3, t4, t5, t6, t7;
    __device__ bool next(int i, Unit& u) const {
        const long L = (long)i * G + c; if (L >= nwg) return false;
        int wgid = (int)L; { const int q = nwg / NXCD, r = nwg % NXCD, xcd = wgid % NXCD, off = wgid / NXCD; wgid = (xcd < r ? xcd * (q + 1) : r * (q + 1) + (xcd - r) * q) + off; }
        const int nig = WGM * nN, gid = wgid / nig, fm = gid * WGM, gsz = (nM - fm) < WGM ? (nM - fm) : WGM;
        u.pm = fm + ((wgid % nig) % gsz); u.pc = (wgid % nig) / gsz;
        const int e = (u.pm >= t1) + (u.pm >= t2) + (u.pm >= t3) + (u.pm >= t4) + (u.pm >= t5) + (u.pm >= t6) + (u.pm >= t7);
        int be = 0; be = u.pm >= t1 ? t1 : be; be = u.pm >= t2 ? t2 : be; be = u.pm >= t3 ? t3 : be; be = u.pm >= t4 ? t4 : be; be = u.pm >= t5 ? t5 : be; be = u.pm >= t6 ? t6 : be; be = u.pm >= t7 ? t7 : be;
        u.pn = e * nN + u.pc; u.pa = acap ? e * acap + (u.pm - be) : u.pm; return true;
    }
    __device__ __forceinline__ void a_ready(const Unit&) const {}
    __device__ __forceinline__ void done(const Unit&) const {}
};

typedef float f32x2_cv __attribute__((ext_vector_type(2))); typedef __bf16 bf16x2_cv __attribute__((ext_vector_type(2)));
__device__ __forceinline__ unsigned cvt_pk_bf16(float lo, float hi) { const f32x2_cv v = {lo, hi}; return __builtin_bit_cast(unsigned, __builtin_convertvector(v, bf16x2_cv)); }
__device__ __forceinline__ float bf_lo(unsigned w) { return __uint_as_float(w << 16); }
__device__ __forceinline__ float bf_hi(unsigned w) { return __uint_as_float(w & 0xffff0000u); }
__device__ __forceinline__ float sigm(float x) { return __builtin_amdgcn_rcpf(1.0f + __builtin_amdgcn_exp2f(-1.4426950408889634f * x)); }
__device__ __forceinline__ float gelu_tanh(float x) { const float t = x + 0.044715f * x * x * x; return x * __builtin_amdgcn_rcpf(1.0f + __builtin_amdgcn_exp2f(-2.302208198f * t)); }
__device__ __forceinline__ u32x4 pack8(const f32x4& a, const f32x4& b) { u32x4 w; w.x = cvt_pk_bf16(a[0], a[1]); w.y = cvt_pk_bf16(a[2], a[3]); w.z = cvt_pk_bf16(b[0], b[1]); w.w = cvt_pk_bf16(b[2], b[3]); return w; }
__device__ __forceinline__ void unpack8(const u32x4& w, f32x4& a, f32x4& b) { a = (f32x4){bf_lo(w.x), bf_hi(w.x), bf_lo(w.y), bf_hi(w.y)}; b = (f32x4){bf_lo(w.z), bf_hi(w.z), bf_lo(w.w), bf_hi(w.w)}; }

__device__ __forceinline__ void unpack8_u8(const u32x2& w, f32x4& a, f32x4& b) { const float k = 1.0f / 255.0f;
    a = (f32x4){(float)(w.x & 0xffu), (float)((w.x >> 8) & 0xffu), (float)((w.x >> 16) & 0xffu), (float)(w.x >> 24)} * k; b = (f32x4){(float)(w.y & 0xffu), (float)((w.y >> 8) & 0xffu), (float)((w.y >> 16) & 0xffu), (float)(w.y >> 24)} * k; }
#define PG8_FOR_AM _Pragma("unroll") for (int ai = 0; ai < 2; ++ai) _Pragma("unroll") for (int m = 0; m < 4; ++m)
#define PG8_FOR_BJ _Pragma("unroll") for (int bj = 0; bj < 2; ++bj)

struct EpiInProj {
    static constexpr bool PERM = true, AFTER_DRAIN = false;
    bf16_t *Q, *KV, *UG, *GA, *GS;
    __device__ __forceinline__ void operator()(const f32x4 (&acc)[2][2][4][2], const Unit& u, int wr, int wc, int fr, int fq) const {
        const int row0 = u.pm * BM + wr * 64 + fr, cl = wc * 32 + 8 * fq, pc = u.pc;
        if (pc < 3) {
            bf16_t* base = pc < 2 ? Q + pc * 256 : KV; const int ld = pc < 2 ? 512 : 256; const float sc = pc < 2 ? 0.125f * 1.4426950408889634f : 1.0f;
            PG8_FOR_AM { bf16_t* rp = base + (size_t)(row0 + ai * HALF + m * 16) * ld + cl;
                PG8_FOR_BJ { *(u32x4*)(rp + bj * HALF) = pack8(acc[ai][bj][m][0] * sc, acc[ai][bj][m][1] * sc); } }
        } else if (pc < 5) {
            PG8_FOR_AM { const int row = row0 + ai * HALF + m * 16, b = row >> 11, s = row & 2047, c = s >> 4, i = s & 15;
                PG8_FOR_BJ { const int ch = (pc - 3) * 256 + bj * HALF + cl, g = ch >> 4, h0 = ch & 15;
                    *(u32x4*)(UG + (size_t)(g * 2048 + b * 128 + c) * 384 + i * 16 + h0) = pack8(acc[ai][bj][m][0], acc[ai][bj][m][1]); } }
        } else {
            unsigned char* base = (unsigned char*)(pc < 9 ? GA : GS) + (pc < 9 ? pc - 5 : pc - 9) * 256;
            PG8_FOR_AM { unsigned char* rp = base + (size_t)(row0 + ai * HALF + m * 16) * 1024 + cl;
                PG8_FOR_BJ { const f32x4 a = acc[ai][bj][m][0], b = acc[ai][bj][m][1]; unsigned q[8];
#pragma unroll
                    for (int k = 0; k < 4; ++k) { q[k] = (unsigned)(sigm(a[k]) * 255.f + 0.5f); q[4 + k] = (unsigned)(sigm(b[k]) * 255.f + 0.5f); }
                    u32x2 w; w.x = q[0] | (q[1] << 8) | (q[2] << 16) | (q[3] << 24); w.y = q[4] | (q[5] << 8) | (q[6] << 16) | (q[7] << 24);
                    *(u32x2*)(rp + bj * HALF) = w; } }
        }
    }
};
struct EpiS {
    static constexpr bool PERM = false, AFTER_DRAIN = false;
    float* SL;
    __device__ __forceinline__ void operator()(const f32x4 (&acc)[2][2][4][2], const Unit& u, int wr, int wc, int fr, int fq) const {
        const int row0 = u.pm * BM + wr * 64 + fr, c0 = wc * 32 + 4 * fq;
        PG8_FOR_AM { float* rp = SL + (size_t)(row0 + ai * HALF + m * 16) * 128 + c0;
#pragma unroll
            for (int n = 0; n < 2; ++n) *(f32x4*)(rp + n * 16) = acc[ai][0][m][n]; }
    }
};
#define PG8_GROUP_FENCE asm volatile("" ::: "memory")
struct EpiY {
    static constexpr bool PERM = true, AFTER_DRAIN = false;
    const bf16_t* UG; const float* Dv; bf16_t* YB;
    __device__ __forceinline__ void operator()(const f32x4 (&acc)[2][2][4][2], const Unit& u, int wr, int wc, int fr, int fq) const {
        constexpr int AHEAD = 3;
        const int row0 = u.pm * BM + wr * 64 + fr, cl = wc * 32 + 8 * fq, g = (u.pm * BM) >> 11, h0 = cl & 15, ch = g * 16 + h0;
        const f32x4 d0 = *(const f32x4*)(Dv + ch), d1 = *(const f32x4*)(Dv + ch + 4);
        u32x4 ub[AHEAD + 1][2];
#define EPIY_LOAD(gi) do { const int row_ = row0 + ((gi) >> 2) * HALF + ((gi) & 3) * 16; _Pragma("unroll") for (int bj = 0; bj < 2; ++bj) ub[(gi) % (AHEAD + 1)][bj] = *(const u32x4*)(UG + (size_t)row_ * 384 + bj * HALF + cl); } while (0)
#pragma unroll
        for (int gi = 0; gi < AHEAD; ++gi) EPIY_LOAD(gi);
#pragma unroll
        for (int gi = 0; gi < 8; ++gi) { const int ai = gi >> 2, m = gi & 3;
            if (gi + AHEAD < 8) EPIY_LOAD(gi + AHEAD);
            PG8_GROUP_FENCE;
            const int row = row0 + ai * HALF + m * 16, b = (row >> 7) & 15, c = row & 127;
            PG8_FOR_BJ { const int col = bj * HALF + cl, j = col >> 4; const size_t t = (size_t)b * 2048 + c * 16 + j;
                f32x4 u0, u1; unpack8(ub[gi % (AHEAD + 1)][bj], u0, u1);
                f32x4 a = acc[ai][bj][m][0] + d0 * u0, bb = acc[ai][bj][m][1] + d1 * u1;
#pragma unroll
                for (int k = 0; k < 4; ++k) { a[k] = gelu_tanh(a[k]); bb[k] = gelu_tanh(bb[k]); }
                *(u32x4*)(YB + t * 512 + ch) = pack8(a, bb); } }
#undef EPIY_LOAD
    }
};
template <int MODE> struct EpiEw {
    static constexpr bool PERM = true, AFTER_DRAIN = false;
    bf16_t* O; int ld; const bf16_t* X; const bf16_t* Y; const float* bias;
    __device__ __forceinline__ void operator()(const f32x4 (&acc)[2][2][4][2], const Unit& u, int wr, int wc, int fr, int fq) const {
        constexpr int AHEAD = MODE == 0 ? 0 : ((MODE == 3 || MODE == 6) ? 2 : 3), NB = AHEAD + 1; constexpr bool HASY = (MODE == 3 || MODE == 6); constexpr float AL = 1.681792830507429f;
        const int row0 = u.pm * BM + wr * 64 + fr, col0 = u.pc * BM + wc * 32 + 8 * fq;
        const bf16_t* Xp = MODE == 4 ? O : X;
        constexpr bool X8 = (MODE == 2 || MODE == 3);
        u32x4 xb[X8 ? 1 : NB][2], yb[HASY ? NB : 1][2]; u32x2 xg[X8 ? NB : 1][2];
        f32x4 bv[2][2];
        if (MODE == 1) { PG8_FOR_BJ { bv[bj][0] = *(const f32x4*)(bias + col0 + bj * HALF); bv[bj][1] = *(const f32x4*)(bias + col0 + bj * HALF + 4); } }
#define EPIEW_LOAD(gi) do { const size_t ro_ = (size_t)(row0 + ((gi) >> 2) * HALF + ((gi) & 3) * 16) * ld + col0; _Pragma("unroll") for (int bj = 0; bj < 2; ++bj) { \
            if (X8) xg[(gi) % NB][bj] = *(const u32x2*)((const unsigned char*)Xp + ro_ + bj * HALF); else xb[(gi) % NB][bj] = *(const u32x4*)(Xp + ro_ + bj * HALF); \
            if (HASY) yb[(gi) % NB][bj] = *(const u32x4*)(Y + ro_ + bj * HALF); } } while (0)
        if (MODE != 0) {
#pragma unroll
            for (int gi = 0; gi < AHEAD; ++gi) EPIEW_LOAD(gi);
        }
#pragma unroll
        for (int gi = 0; gi < 8; ++gi) { const int ai = gi >> 2, m = gi & 3;
            if (MODE != 0) { if (gi + AHEAD < 8) EPIEW_LOAD(gi + AHEAD); PG8_GROUP_FENCE; }
            const size_t ro = (size_t)(row0 + ai * HALF + m * 16) * ld + col0;
            PG8_FOR_BJ { const size_t off = ro + bj * HALF; f32x4 a = acc[ai][bj][m][0], b = acc[ai][bj][m][1];
                if (MODE == 1) { f32x4 y0, y1; unpack8(xb[gi % NB][bj], y0, y1); a += bv[bj][0]; b += bv[bj][1];
#pragma unroll
                    for (int k = 0; k < 4; ++k) { a[k] = y0[k] * sigm(a[k]); b[k] = y1[k] * sigm(b[k]); } }
                if (MODE == 2) { f32x4 x0, x1; unpack8_u8(xg[gi % NB][bj], x0, x1); a *= x0; b *= x1; }
                if (MODE == 3) { f32x4 x0, x1, y0, y1; unpack8_u8(xg[gi % NB][bj], x0, x1); unpack8(yb[gi % NB][bj], y0, y1); a = y0 + x0 * a; b = y1 + x1 * b; }
                if (MODE == 5) { f32x4 x0, x1; unpack8(xb[gi % NB][bj], x0, x1); a += x0 * AL; b += x1 * AL; }
                if (MODE == 6) { f32x4 x0, x1, y0, y1; unpack8(xb[gi % NB][bj], x0, x1); unpack8(yb[gi % NB][bj], y0, y1); a += x0 * AL + y0; b += x1 * AL + y1; }
                if (MODE == 4) { f32x4 y0, y1; unpack8(xb[gi % NB][bj], y0, y1);
#pragma unroll
                    for (int k = 0; k < 4; ++k) { a[k] = y0[k] * sigm(a[k]); b[k] = y1[k] * sigm(b[k]); } }
                *(u32x4*)(O + off) = pack8(a, b); } }
#undef EPIEW_LOAD
    }
};
struct EpiSwiGLU {
    static constexpr bool PERM = true, AFTER_DRAIN = false;
    bf16_t* H; int ld;
    __device__ __forceinline__ void operator()(const f32x4 (&acc)[2][2][4][2], const Unit& u, int wr, int wc, int fr, int fq) const {
        const int row0 = u.pm * BM + wr * 64 + fr, col0 = u.pc * HALF + wc * 32 + 8 * fq;
        PG8_FOR_AM { f32x4 a = acc[ai][0][m][0], b = acc[ai][0][m][1]; const f32x4 ua = acc[ai][1][m][0], ub = acc[ai][1][m][1];
#pragma unroll
            for (int k = 0; k < 4; ++k) { a[k] = a[k] * sigm(a[k]) * ua[k]; b[k] = b[k] * sigm(b[k]) * ub[k]; }
            *(u32x4*)(H + (size_t)(row0 + ai * HALF + m * 16) * ld + col0) = pack8(a, b); }
    }
};

template <class Epi, class Sched, bool ALIGN_EPI = false, bool SP2 = false, bool GATHER = false>
__device__ __forceinline__ void gemm_phase(PG8_LAS unsigned char* lds, const Gemm g, const Sched& S, const Epi& E, const int tid_in, const int* gidx = nullptr, const int gmax = 0) {
    static_assert(!GATHER || SP2, "the gather path is written for the SP2 loop");
    const int tid = opaque_v(tid_in);
    const int wid = __builtin_amdgcn_readfirstlane(tid >> 6), lane = tid & 63, wr = wid >> 2, wc = wid & 3, fr = lane & 15, fq = lane >> 4;
    const int K = g.K, nt = K / BK;
    unsigned voffA[2], voffB[2]; int gR[2], gC2[2];
#pragma unroll
    for (int i = 0; i < 2; ++i) { int R, C; stage_rc(tid * 16 + i * 8192, R, C); const int Rb = Epi::PERM ? ((R & ~31) + perm32(R & 31)) : R;
        voffA[i] = (unsigned)(R * g.lda + C) * 2u; voffB[i] = (unsigned)(Rb * g.ldb + C) * 2u; gR[i] = R; gC2[i] = C * 2; }
    unsigned vC0[2], vC1[2];
#define PG8_GDMA(slot, pa_) do { if (wid < 4) __builtin_amdgcn_global_load_lds((const unsigned*)(gidx + (size_t)(pa_) * BM + wid * 64 + lane), (PG8_LAS unsigned*)(lds + STAGE_BYTES + 2048 + (slot) * 1024 + wid * 256), 4, 0, 0); } while (0)
#define PG8_GREAD(d0, d1, slot) do { const PG8_LAS unsigned* ix_ = (const PG8_LAS unsigned*)(lds + STAGE_BYTES + 2048 + (slot) * 1024); _Pragma("unroll") for (int _i = 0; _i < 2; ++_i) { \
        unsigned r0_ = ix_[gR[_i]], r1_ = ix_[HALF + gR[_i]]; r0_ = r0_ > (unsigned)gmax ? (unsigned)gmax : r0_; r1_ = r1_ > (unsigned)gmax ? (unsigned)gmax : r1_; \
        d0[_i] = r0_ * (unsigned)(g.lda * 2) + (unsigned)gC2[_i]; d1[_i] = r1_ * (unsigned)(g.lda * 2) + (unsigned)gC2[_i]; } } while (0)
    const size_t kstep = (size_t)(BK * 2);
    const size_t hstepA = (size_t)HALF * g.lda * 2, hstepB = (size_t)HALF * g.ldb * 2;
    const size_t tstepA = 2 * hstepA, tstepB = 2 * hstepB;
    const unsigned ldsw = (unsigned)wid * 1024u;
    const int aoff = lds_byte(wr * 64 + fr, fq * 8), boff = lds_byte(wc * 32 + fr, fq * 8);
#define PG8_SA(b, h) (((b) * 2 + (h)) * HTB)
#define PG8_SB(b, h) ((4 + (b) * 2 + (h)) * HTB)
#define PG8_STAGE(bufoff, gbase, voff) do { _Pragma("unroll") for (int _i = 0; _i < 2; ++_i) \
        __builtin_amdgcn_global_load_lds((const unsigned*)((const char*)(gbase) + (voff)[_i]), (PG8_LAS unsigned*)(lds + (bufoff) + ldsw + _i * 8192), 16, 0, 0); } while (0)
#define PG8_LDA(dst, b, h) do { _Pragma("unroll") for (int m = 0; m < 4; ++m) _Pragma("unroll") for (int k = 0; k < 2; ++k) dst[m][k] = *(const PG8_LAS bf16x8*)(lds + PG8_SA(b, h) + aoff + m * 2048 + k * 1024); } while (0)
#define PG8_LDB(dst, b, h) do { _Pragma("unroll") for (int n = 0; n < 2; ++n) _Pragma("unroll") for (int k = 0; k < 2; ++k) dst[n][k] = *(const PG8_LAS bf16x8*)(lds + PG8_SB(b, h) + boff + n * 2048 + k * 1024); } while (0)
#define PG8_MMA(ai, bj, At, Bt) do { __builtin_amdgcn_s_setprio(1); _Pragma("unroll") for (int m = 0; m < 4; ++m) _Pragma("unroll") for (int n = 0; n < 2; ++n) _Pragma("unroll") for (int k = 0; k < 2; ++k) \
        acc[ai][bj][m][n] = __builtin_amdgcn_mfma_f32_16x16x32_bf16(Bt[n][k], At[m][k], acc[ai][bj][m][n], 0, 0, 0); __builtin_amdgcn_s_setprio(0); } while (0)
#define PG8_WAIT_V(n) asm volatile("s_waitcnt vmcnt(" #n ")" ::: "memory")
#define PG8_WAIT_L(n) asm volatile("s_waitcnt lgkmcnt(" #n ")" ::: "memory")
#define PG8_BAR __builtin_amdgcn_s_barrier()
#define PG8_SCHED __builtin_amdgcn_sched_barrier(0)
    Unit cur, nxt; int ui = 0;
    if (!S.next(0, cur)) return;
    const float zz = opaque_f(0.f);
    f32x4 acc[2][2][4][2];
#pragma unroll
    for (int a = 0; a < 2; ++a)
#pragma unroll
        for (int b = 0; b < 2; ++b)
#pragma unroll
            for (int m = 0; m < 4; ++m)
#pragma unroll
                for (int n = 0; n < 2; ++n) acc[a][b][m][n] = (f32x4){zz, zz, zz, zz};
    bf16x8 At[4][2], B0[2][2], B1[2][2];
    const char* cA = GATHER ? (const char*)g.A : (const char*)g.A + (size_t)cur.pa * tstepA; const char* cB = (const char*)g.Bt + (size_t)cur.pn * tstepB;
    S.a_ready(cur);
    if constexpr (GATHER) { PG8_GDMA(0, cur.pa); PG8_WAIT_V(0); PG8_BAR; PG8_GREAD(vC0, vC1, 0); }
    if constexpr (SP2) {
        PG8_STAGE(PG8_SB(0, 0), cB, voffB); PG8_STAGE(PG8_SB(0, 1), cB + hstepB, voffB);
        if constexpr (GATHER) { PG8_STAGE(PG8_SA(0, 0), cA, vC0); PG8_STAGE(PG8_SA(0, 1), cA, vC1); } else { PG8_STAGE(PG8_SA(0, 0), cA, voffA); PG8_STAGE(PG8_SA(0, 1), cA + hstepA, voffA); }
        if (wr == 1) PG8_BAR;
        PG8_WAIT_V(2); PG8_BAR;
        PG8_STAGE(PG8_SB(1, 0), cB + kstep, voffB); if constexpr (GATHER) PG8_STAGE(PG8_SA(1, 0), cA + kstep, vC0); else PG8_STAGE(PG8_SA(1, 0), cA + kstep, voffA); PG8_STAGE(PG8_SB(1, 1), cB + hstepB + kstep, voffB);
        PG8_WAIT_V(6); PG8_BAR;
    } else {
        PG8_STAGE(PG8_SB(0, 0), cB, voffB); PG8_STAGE(PG8_SA(0, 0), cA, voffA); PG8_STAGE(PG8_SB(0, 1), cB + hstepB, voffB); PG8_STAGE(PG8_SA(0, 1), cA + hstepA, voffA);
        if (wr == 1) PG8_BAR;
        PG8_WAIT_V(4); PG8_BAR;
        PG8_STAGE(PG8_SB(1, 0), cB + kstep, voffB); PG8_STAGE(PG8_SA(1, 0), cA + kstep, voffA); PG8_STAGE(PG8_SB(1, 1), cB + hstepB + kstep, voffB);
        PG8_WAIT_V(6); PG8_BAR;
    }
    for (;;) {
        const bool has_next = S.next(ui + 1, nxt);
        const char* nA = GATHER ? cA : (has_next ? (const char*)g.A + (size_t)nxt.pa * tstepA : cA); const char* nB = has_next ? (const char*)g.Bt + (size_t)nxt.pn * tstepB : cB;
        if constexpr (GATHER) { if (has_next) PG8_GDMA((ui + 1) & 1, nxt.pa); }
        for (int t = 0; t < nt; t += 2) {
            const bool last = (t == nt - 2);
            const char* a1 = cA + (size_t)(t + 1) * kstep;
            const char* a2 = last ? nA : cA + (size_t)(t + 2) * kstep; const char* b2 = last ? nB : cB + (size_t)(t + 2) * kstep;
            const char* a3 = a2 + kstep; const char* b3 = b2 + kstep;
            if (last && has_next) S.a_ready(nxt);
            if constexpr (SP2) {
            unsigned w0[2], w1[2];
            if constexpr (GATHER) { _Pragma("unroll") for (int i = 0; i < 2; ++i) { w0[i] = vC0[i]; w1[i] = vC1[i]; } if (last && has_next) PG8_GREAD(w0, w1, (ui + 1) & 1); }
            PG8_LDB(B0, 0, 0); PG8_LDB(B1, 0, 1); PG8_SCHED; PG8_LDA(At, 0, 0); if constexpr (GATHER) PG8_STAGE(PG8_SA(1, 1), a1, vC1); else PG8_STAGE(PG8_SA(1, 1), a1 + hstepA, voffA);
            PG8_WAIT_V(8); PG8_WAIT_L(0); PG8_BAR; PG8_MMA(0, 0, At, B0); PG8_MMA(0, 1, At, B1); PG8_BAR; PG8_SCHED;
            PG8_LDA(At, 0, 1); PG8_STAGE(PG8_SB(0, 0), b2, voffB); PG8_STAGE(PG8_SB(0, 1), b2 + hstepB, voffB); if constexpr (GATHER) PG8_STAGE(PG8_SA(0, 0), a2, w0); else PG8_STAGE(PG8_SA(0, 0), a2, voffA);
            PG8_WAIT_V(8); PG8_WAIT_L(0); PG8_BAR; PG8_MMA(1, 0, At, B0); PG8_MMA(1, 1, At, B1); PG8_BAR; PG8_SCHED;
            PG8_LDB(B0, 1, 0); PG8_LDB(B1, 1, 1); PG8_SCHED; PG8_LDA(At, 1, 0); if constexpr (GATHER) PG8_STAGE(PG8_SA(0, 1), a2, w1); else PG8_STAGE(PG8_SA(0, 1), a2 + hstepA, voffA);
            PG8_WAIT_V(8); PG8_WAIT_L(0); PG8_BAR; PG8_MMA(0, 0, At, B0); PG8_MMA(0, 1, At, B1); PG8_BAR; PG8_SCHED;
            PG8_LDA(At, 1, 1); PG8_STAGE(PG8_SB(1, 0), b3, voffB); PG8_STAGE(PG8_SB(1, 1), b3 + hstepB, voffB); if constexpr (GATHER) PG8_STAGE(PG8_SA(1, 0), a3, w0); else PG8_STAGE(PG8_SA(1, 0), a3, voffA);
            PG8_WAIT_V(8); PG8_WAIT_L(0); PG8_BAR; PG8_MMA(1, 0, At, B0); PG8_MMA(1, 1, At, B1); PG8_BAR; PG8_SCHED;
            } else {
            PG8_LDB(B0, 0, 0); PG8_SCHED; PG8_LDA(At, 0, 0); PG8_STAGE(PG8_SA(1, 1), a1 + hstepA, voffA);
            PG8_WAIT_L(8); PG8_BAR; PG8_WAIT_L(0); PG8_MMA(0, 0, At, B0); PG8_BAR; PG8_SCHED;
            PG8_LDB(B1, 0, 1); PG8_STAGE(PG8_SB(0, 0), b2, voffB);
            PG8_BAR; PG8_WAIT_L(0); PG8_MMA(0, 1, At, B1); PG8_BAR;
            PG8_LDA(At, 0, 1); PG8_STAGE(PG8_SA(0, 0), a2, voffA);
            PG8_BAR; PG8_WAIT_L(0); PG8_MMA(1, 0, At, B0); PG8_BAR; PG8_SCHED;
            PG8_STAGE(PG8_SB(0, 1), b2 + hstepB, voffB);
            PG8_WAIT_V(6); PG8_BAR; PG8_MMA(1, 1, At, B1); PG8_BAR;
            PG8_LDB(B0, 1, 0); PG8_SCHED; PG8_LDA(At, 1, 0); PG8_STAGE(PG8_SA(0, 1), a2 + hstepA, voffA);
            PG8_WAIT_L(8); PG8_BAR; PG8_WAIT_L(0); PG8_MMA(0, 0, At, B0); PG8_BAR; PG8_SCHED;
            PG8_LDB(B1, 1, 1); PG8_STAGE(PG8_SB(1, 0), b3, voffB);
            PG8_BAR; PG8_WAIT_L(0); PG8_MMA(0, 1, At, B1); PG8_BAR;
            PG8_LDA(At, 1, 1); PG8_STAGE(PG8_SA(1, 0), a3, voffA);
            PG8_BAR; PG8_WAIT_L(0); PG8_MMA(1, 0, At, B0); PG8_BAR; PG8_SCHED;
            PG8_STAGE(PG8_SB(1, 1), b3 + hstepB, voffB);
            PG8_WAIT_V(6); PG8_BAR; PG8_MMA(1, 1, At, B1); PG8_BAR;
            }
        }
        if constexpr (ALIGN_EPI) { if (wr == 0) PG8_BAR; }
        if constexpr (!Epi::AFTER_DRAIN) { const int l2_ = lane_id(); E(acc, cur, wr, wc, l2_ & 15, l2_ >> 4); S.done(cur); }
        if (!has_next) break;
#pragma unroll
        for (int a = 0; a < 2; ++a)
#pragma unroll
            for (int b = 0; b < 2; ++b)
#pragma unroll
                for (int m = 0; m < 4; ++m)
#pragma unroll
                    for (int n = 0; n < 2; ++n) acc[a][b][m][n] = (f32x4){zz, zz, zz, zz};
        cur = nxt; cA = nA; cB = nB; ++ui;
        if constexpr (GATHER) PG8_GREAD(vC0, vC1, ui & 1);
        if constexpr (ALIGN_EPI) { if (wr == 1) PG8_BAR; }
    }
    PG8_WAIT_V(0);
    if constexpr (!ALIGN_EPI) { if (wr == 0) PG8_BAR; }
    PG8_BAR;
#undef PG8_GDMA
#undef PG8_GREAD
#undef PG8_SA
#undef PG8_SB
#undef PG8_STAGE
#undef PG8_LDA
#undef PG8_LDB
#undef PG8_MMA
#undef PG8_WAIT_V
#undef PG8_WAIT_L
#undef PG8_BAR
#undef PG8_SCHED
}
}

constexpr int NWAVES = 8;
constexpr int DM = 1024, BATCH = 16, SEQ = 2048, T = BATCH * SEQ, DEPTH = 4;
constexpr int IN_COLS = 3328, DFF = 2816, DFFE = 3584, NEXP = 8, PLE = 256;
constexpr int CH = 16;
constexpr int NCHUNK = SEQ / CH;
constexpr int UGROWS = 32 * BATCH * NCHUNK;
constexpr int UGLD = 384;
constexpr int XSROWS = 2 * T + NEXP * 256;
constexpr float LN_EPS = 1e-5f;
constexpr float ALPHA = 1.681792830507429f;
constexpr float LOG2E = 1.4426950408889634f;

constexpr size_t MiB = 1u << 20;
constexpr size_t WS_CTL = 0, CTL_ZERO_BYTES = 1 * MiB;
constexpr size_t WS_WIN = 1 * MiB;
constexpr size_t WS_WGLU = WS_WIN + 26 * MiB;
constexpr size_t WS_WBA = WS_WGLU + 2 * MiB;
constexpr size_t WS_WBS = WS_WBA + 4 * MiB;
constexpr size_t WS_WOUT = WS_WBS + 4 * MiB;
constexpr size_t WS_WGU = WS_WOUT + 8 * MiB;
constexpr size_t WS_WDN = WS_WGU + 22 * MiB;
constexpr size_t WS_MGU = WS_WDN + 11 * MiB;
constexpr size_t WS_MDN = WS_MGU + 224 * MiB;
constexpr size_t WS_PPJ = WS_MDN + 112 * MiB;
constexpr size_t WS_PGT = WS_PPJ + 2 * MiB;
constexpr size_t WS_SG = WS_PGT + 8 * MiB;
constexpr size_t WS_TZE = WS_SG + 16 * MiB;
constexpr size_t WS_MISC = WS_TZE + 24 * MiB;
constexpr size_t WS_PB = WS_MISC + 2 * MiB;
constexpr size_t WS_XB = WS_PB + 64 * MiB;
constexpr size_t WS_PP = WS_XB + 64 * MiB;
constexpr size_t WS_XS = WS_PP + 64 * MiB;
constexpr size_t WS_MIX = WS_XS + 512 * MiB;
constexpr size_t WS_Q = WS_MIX;
constexpr size_t WS_KV = WS_Q + 32 * MiB;
constexpr size_t WS_UG = WS_KV + 16 * MiB;
constexpr size_t WS_GA = WS_UG + 48 * MiB;
constexpr size_t WS_GS = WS_GA + 64 * MiB;
constexpr size_t WS_SL = WS_GS + 64 * MiB;
constexpr size_t WS_AO = WS_SL + 32 * MiB;
constexpr size_t WS_YB = WS_AO + 32 * MiB;
constexpr size_t WS_SO = WS_YB + 32 * MiB;
constexpr size_t WS_T1 = WS_SO + 32 * MiB;
constexpr size_t WS_MG = WS_T1 + 64 * MiB;
constexpr size_t WS_HB = WS_MIX;
constexpr size_t WS_HBUF = WS_MIX + 480 * MiB;
constexpr size_t WS_END = WS_HBUF + 64 * MiB;
static_assert(WS_MG + 64 * MiB == WS_HBUF && (size_t)XSROWS * DFFE * 2 <= 480 * MiB && (size_t)XSROWS * DM * 2 <= 512 * MiB, "d_ws map");

constexpr int CW_BAR = 4096;
constexpr int CW_MOE = 16384;

constexpr int RING_OFF = 0, RING_BYTES = 131072;
constexpr int LDSCTL_OFF = RING_BYTES, MISC_OFF = LDSCTL_OFF + 320;
constexpr int LDS_BYTES = 147456;

#define GAS __attribute__((address_space(1)))
#define LAS __attribute__((address_space(3)))
typedef unsigned short bf16;
typedef unsigned v4u __attribute__((ext_vector_type(4)));
typedef unsigned v2u __attribute__((ext_vector_type(2)));
typedef float f32x4 __attribute__((ext_vector_type(4)));
typedef float f32x2 __attribute__((ext_vector_type(2)));
typedef short bf16x8 __attribute__((ext_vector_type(8)));
typedef short bf16x4 __attribute__((ext_vector_type(4)));
typedef GAS unsigned gu32;
#define RLX_AGENT __ATOMIC_RELAXED, __HIP_MEMORY_SCOPE_AGENT
#define LDS_WAIT() asm volatile("s_waitcnt lgkmcnt(0)" ::: "memory")
#define VM_WAIT() asm volatile("s_waitcnt vmcnt(0)" ::: "memory")
__device__ __forceinline__ unsigned f2bf(float f) { unsigned u = __builtin_bit_cast(unsigned, f); return (u + 0x7fffu + ((u >> 16) & 1u)) >> 16; }
__device__ __forceinline__ unsigned pk2(float lo, float hi) { return f2bf(lo) | (f2bf(hi) << 16); }

#define XB_TMO      128
#define XB_XCNT(j)  (256  + 64 * (j))
#define XB_XSUB(j)  (1280 + 64 * (j))
#define XB_XGEN(j)  (2304 + 64 * (j))
#define XB_TOP      3328
#define XB_TOPGEN   3392
#define XCD_BAR_WORDS 3456
#define XB_SPIN_CAP (1u << 18)

__device__ __forceinline__ unsigned xb_ld(unsigned* p)              { return __hip_atomic_load(p, __ATOMIC_RELAXED, __HIP_MEMORY_SCOPE_AGENT); }
__device__ __forceinline__ unsigned xb_add(unsigned* p, unsigned v) { return __hip_atomic_fetch_add(p, v, __ATOMIC_RELAXED, __HIP_MEMORY_SCOPE_AGENT); }
__device__ __forceinline__ unsigned xb_xcc_id() { return (unsigned)__builtin_amdgcn_s_getreg((3 << 11) | 20) & 0xFu; }
#define XB_SPIN(cond, bar) do { unsigned _sp = 0; while (cond) { __builtin_amdgcn_s_sleep(1); \
    if ((++_sp & 255u) == 0u) { if (xb_ld(&(bar)[XB_TMO])) break; if (_sp > XB_SPIN_CAP) { atomicAdd(&(bar)[XB_TMO], 1u); break; } } } } while (0)

struct XcdBarrier { unsigned* bar; unsigned x; volatile LAS unsigned* st; };

__device__ __forceinline__ XcdBarrier xcd_barrier_post(unsigned* bar, volatile LAS unsigned* st, int tid) {
    XcdBarrier b; b.bar = bar; b.x = xb_xcc_id(); b.st = st;
    if (tid == 0) (void)xb_add(&bar[XB_XCNT(b.x)], 1u);
    return b;
}
__device__ __forceinline__ void xcd_barrier_complete(unsigned* bar, unsigned x, unsigned& nloc, unsigned& nx) {
    const unsigned G = gridDim.x * gridDim.y * gridDim.z;
    unsigned sum, cnt, mine, sp = 0u;
    for (;;) {
        sum = 0u; cnt = 0u; mine = 0u;
#pragma unroll 1
        for (unsigned j = 0; j < 16; ++j) { const unsigned c = xb_ld(&bar[XB_XCNT(j)]); sum += c; cnt += (c > 0u) ? 1u : 0u; mine = (j == x) ? c : mine; }
        if (sum == G) break;
        __builtin_amdgcn_s_sleep(1);
        if ((++sp & 255u) == 0u) { if (xb_ld(&bar[XB_TMO])) break; if (sp > XB_SPIN_CAP) { atomicAdd(&bar[XB_TMO], 1u); break; } }
    }
    nloc = mine > 0u ? mine : 1u; nx = cnt > 0u ? cnt : 1u;
}
__device__ __forceinline__ void xcd_barrier(const XcdBarrier& b, int tid) {
    asm volatile("s_waitcnt vmcnt(0)" ::: "memory");
    __syncthreads();
    if (tid == 0) {
        unsigned* bar = b.bar; asm volatile("" : "+s"(bar));
        __builtin_amdgcn_s_waitcnt(0);
        unsigned nloc = b.st[0], nx = b.st[1];
        if (nloc == 0u) { xcd_barrier_complete(bar, b.x, nloc, nx); b.st[0] = nloc; b.st[1] = nx; }
        const unsigned old = xb_add(&bar[XB_XSUB(b.x)], 1u);
        const unsigned gen = old / nloc;
        if (old + 1u == (gen + 1u) * nloc) {
            __builtin_amdgcn_fence(__ATOMIC_RELEASE, "agent");
            asm volatile("s_waitcnt vmcnt(0)" ::: "memory");
            const unsigned og = xb_add(&bar[XB_TOP], 1u);
            const unsigned tg = og / nx;
            if (og + 1u == (tg + 1u) * nx) xb_add(&bar[XB_TOPGEN], 1u);
            else XB_SPIN(xb_ld(&bar[XB_TOPGEN]) == tg, bar);
            __builtin_amdgcn_fence(__ATOMIC_ACQUIRE, "agent");
            xb_add(&bar[XB_XGEN(b.x)], 1u);
            asm volatile("s_waitcnt vmcnt(0)" ::: "memory");
        } else {
            XB_SPIN(xb_ld(&bar[XB_XGEN(b.x)]) == gen, bar);
            __builtin_amdgcn_fence(__ATOMIC_ACQUIRE, "agent");
            asm volatile("s_waitcnt vmcnt(0)" ::: "memory");
        }
    }
    __syncthreads();
}

struct Args { const float* in[29]; float* out; unsigned char* ws; int ph_lo, ph_hi; };
enum { I_X = 0, I_P, I_RELB, I_WIN, I_SINKS, I_LRE, I_LIM, I_LOGDT, I_BRE, I_BIM, I_CRE, I_CIM, I_SSMD, I_WGLU, I_BGLU, I_WBA, I_WBS, I_WOUT, I_LN1G, I_LN1B,
       I_FGU, I_FDN, I_ROUTER, I_MGU, I_MDN, I_PPROJ, I_PGATE, I_LN2G, I_LN2B };

typedef const __attribute__((address_space(4))) unsigned char* kptr_t;
__device__ __forceinline__ kptr_t karg_base() { kptr_t k = (kptr_t)__builtin_amdgcn_kernarg_segment_ptr(); asm volatile("" : "+s"(k)); return k; }
__device__ __forceinline__ const float* in_ptr(int i) { return *(const float* const __attribute__((address_space(4)))*)(karg_base() + 8 * i); }
__device__ __forceinline__ float* out_ptr() { return *(float* const __attribute__((address_space(4)))*)(karg_base() + 8 * 29); }
__device__ __forceinline__ unsigned char* ws_ptr() { return *(unsigned char* const __attribute__((address_space(4)))*)(karg_base() + 8 * 30); }
static_assert(sizeof(Args) == 8 * 31 + 8, "Args layout");
#define WSP(T, off) ((T*)(ws_ptr() + (off)))

__device__ __forceinline__ float wave_sum(float v, int lane) {
#pragma unroll
    for (int o = 1; o < 64; o <<= 1) v += pg8::shx(v, o, lane);
    return v;
}

struct TrItem { const float* src; bf16* dst; int N, K; };
__device__ __forceinline__ void tr_desc1(TrItem& d, const float* W, int K, int N, bf16* WT, int ilv, int item) {
    const int nblk = N / 32, kb = item / nblk, nb = item % nblk, k0 = 64 * kb, n0 = 32 * nb;
    int r0 = n0;
    if (ilv > 0) { r0 = n0 < ilv ? (n0 / 128) * 256 + (n0 % 128) : ((n0 - ilv) / 128) * 256 + 128 + ((n0 - ilv) % 128); }
    d.src = W + (size_t)k0 * N + n0; d.dst = WT + (size_t)r0 * K + k0; d.N = N; d.K = K;
}
__device__ __forceinline__ bool tr_family(int& r, TrItem& d, const float* W, int nb, int K, int N, bf16* WT, int ilv) {
    const int per = (K / 64) * (N / 32), tot = nb * per;
    if (r < tot) { const int mi = r / per; tr_desc1(d, W + (size_t)mi * K * N, K, N, WT + (size_t)mi * K * N, ilv, r % per); return true; }
    r -= tot; return false;
}
constexpr int TR_NIT = 4 * 16 * 104 + 4 * 8 * 16 + 2 * (4 * 8 * 32) + 4 * 16 * 32 + 2 * 16 * 176 + 2 * 44 * 32 + 16 * 16 * 224 + 16 * 56 * 32 + 4 * 4 * 32 + 4 * 16 * 32;
__device__ __forceinline__ void tr_desc(TrItem& d, int it) {
    int r = it;
    if (tr_family(r, d, in_ptr(I_WIN), 4, 1024, 3328, WSP(bf16, WS_WIN), 0)) return;
    if (tr_family(r, d, in_ptr(I_WGLU), 4, 512, 512, WSP(bf16, WS_WGLU), 0)) return;
    if (tr_family(r, d, in_ptr(I_WBA), 4, 512, 1024, WSP(bf16, WS_WBA), 0)) return;
    if (tr_family(r, d, in_ptr(I_WBS), 4, 512, 1024, WSP(bf16, WS_WBS), 0)) return;
    if (tr_family(r, d, in_ptr(I_WOUT), 4, 1024, 1024, WSP(bf16, WS_WOUT), 0)) return;
    if (tr_family(r, d, in_ptr(I_FGU), 2, 1024, 2 * 2816, WSP(bf16, WS_WGU), 2816)) return;
    if (tr_family(r, d, in_ptr(I_FDN), 2, 2816, 1024, WSP(bf16, WS_WDN), 0)) return;
    if (tr_family(r, d, in_ptr(I_MGU), 16, 1024, 2 * 3584, WSP(bf16, WS_MGU), 3584)) return;
    if (tr_family(r, d, in_ptr(I_MDN), 16, 3584, 1024, WSP(bf16, WS_MDN), 0)) return;
    if (tr_family(r, d, in_ptr(I_PPROJ), 4, 256, 1024, WSP(bf16, WS_PPJ), 0)) return;
    tr_family(r, d, in_ptr(I_PGATE), 4, 1024, 1024, WSP(bf16, WS_PGT), 0);
}
__device__ __forceinline__ void tr_load(float (&v)[32], const TrItem& d, int lane) {
    const float* p = d.src + (size_t)(lane >> 5) * d.N + (lane & 31);
#pragma unroll
    for (int i = 0; i < 32; ++i) v[i] = *(const GAS float*)(p + (size_t)(2 * i) * d.N);
}
__device__ __forceinline__ void tr_store(const float (&v)[32], const TrItem& d, LAS float* scr, int lane) {
#pragma unroll
    for (int i = 0; i < 32; ++i) scr[(2 * i + (lane >> 5)) * 33 + (lane & 31)] = v[i];
    LDS_WAIT(); asm volatile("" ::: "memory");
    const int c = lane & 7;
#pragma unroll
    for (int j = 0; j < 4; ++j) { const int n = (lane >> 3) + 8 * j; const LAS float* s = scr + (8 * c) * 33 + n;
        v4u o; o.x = pk2(s[0 * 33], s[1 * 33]); o.y = pk2(s[2 * 33], s[3 * 33]); o.z = pk2(s[4 * 33], s[5 * 33]); o.w = pk2(s[6 * 33], s[7 * 33]);
        *(GAS v4u*)(d.dst + (size_t)n * d.K + 8 * c) = o; }
    LDS_WAIT(); asm volatile("" ::: "memory");
}

__device__ __forceinline__ void ssm_build(LAS unsigned char* lds, int l, int g, int tid) {
    unsigned char* ws = ws_ptr();
    LAS f32x2* lamd = (LAS f32x2*)lds;
    LAS f32x2* bbar = lamd + 17 * 64;
    LAS f32x2* cc = bbar + 64 * 16;
    LAS float* Kt = (LAS float*)(cc + 16 * 64);
    const int lg = l * 32 + g;
    if (tid < 64) {
        const int p = tid; const double lr = in_ptr(I_LRE)[lg * 64 + p], li = in_ptr(I_LIM)[lg * 64 + p], dt = exp((double)in_ptr(I_LOGDT)[lg]);
        for (int d = 0; d <= 16; ++d) { const double mag = exp(d * lr * dt), ang = d * li * dt; lamd[d * 64 + p] = (f32x2){(float)(mag * cos(ang)), (float)(mag * sin(ang))}; }
        const double m1 = exp(lr * dt), br = m1 * cos(li * dt) - 1.0, bi = m1 * sin(li * dt), den = lr * lr + li * li;
        const double cr = (br * lr + bi * li) / den, ci = (bi * lr - br * li) / den;
        for (int h = 0; h < 16; ++h) { const double xr = in_ptr(I_BRE)[(lg * 64 + p) * 16 + h], xi = in_ptr(I_BIM)[(lg * 64 + p) * 16 + h];
            bbar[p * 16 + h] = (f32x2){(float)(cr * xr - ci * xi), (float)(cr * xi + ci * xr)}; }
        const double mL = exp(16 * lr * dt), aL = 16 * li * dt;
        ((f32x2*)(ws + WS_MISC))[lg * 64 + p] = (f32x2){(float)(mL * cos(aL)), (float)(mL * sin(aL))};
    }
    for (int i = tid; i < 1024; i += 512) { const int h = i >> 6, p = i & 63; cc[i] = (f32x2){in_ptr(I_CRE)[(lg * 16 + h) * 64 + p], in_ptr(I_CIM)[(lg * 16 + h) * 64 + p]}; }
    __syncthreads();
    for (int o = tid; o < 4096; o += 512) { const int d = o >> 8, h = (o >> 4) & 15, h2 = o & 15; float s = 0.f;
        for (int p = 0; p < 64; ++p) { const f32x2 c = cc[h * 64 + p], lm = lamd[d * 64 + p], b = bbar[p * 16 + h2];
            const float tr = c.x * lm.x - c.y * lm.y, ti = c.x * lm.y + c.y * lm.x; s += tr * b.x - ti * b.y; }
        Kt[o] = s; }
    __syncthreads();
    bf16* SG = (bf16*)(ws + WS_SG) + (size_t)lg * 256 * 256;
    for (int ck = tid; ck < 256 * 32; ck += 512) { const int n = ck >> 5, k0 = (ck & 31) * 8, i = k0 >> 4, h0 = k0 & 15; float v[8];
#pragma unroll
        for (int j = 0; j < 8; ++j) { if (n < 128) { const int p = n & 63; const f32x2 lm = lamd[(15 - i) * 64 + p], b = bbar[p * 16 + h0 + j];
                v[j] = n < 64 ? lm.x * b.x - lm.y * b.y : lm.x * b.y + lm.y * b.x; } else v[j] = 0.f; }
        v4u o; o.x = pk2(v[0], v[1]); o.y = pk2(v[2], v[3]); o.z = pk2(v[4], v[5]); o.w = pk2(v[6], v[7]);
        *(GAS v4u*)(SG + (size_t)n * 256 + k0) = o; }
    bf16* TZ = (bf16*)(ws + WS_TZE) + (size_t)lg * 256 * 384;
    for (int ck = tid; ck < 256 * 48; ck += 512) { const int n = ck / 48, k0 = (ck % 48) * 8, j = n >> 4, h = n & 15; float v[8];
#pragma unroll
        for (int q = 0; q < 8; ++q) { const int k = k0 + q;
            if (k < 256) { const int i = k >> 4, h2 = k & 15; v[q] = i <= j ? Kt[((j - i) * 16 + h) * 16 + h2] : 0.f; }
            else { const int p = (k - 256) & 63; const f32x2 c = cc[h * 64 + p], lm = lamd[(j + 1) * 64 + p];
                v[q] = k < 320 ? c.x * lm.x - c.y * lm.y : -(c.x * lm.y + c.y * lm.x); } }
        v4u o; o.x = pk2(v[0], v[1]); o.y = pk2(v[2], v[3]); o.z = pk2(v[4], v[5]); o.w = pk2(v[6], v[7]);
        *(GAS v4u*)(TZ + (size_t)n * 384 + k0) = o; }
    __syncthreads();
}

__device__ __forceinline__ void cvt_rows(const float* src, bf16* dst, size_t n8, size_t gtid, size_t gthreads) {
    for (size_t i0 = gtid; i0 < n8; i0 += 4 * gthreads) {
        f32x4 a[4], b[4];
#pragma unroll
        for (int u = 0; u < 4; ++u) { const size_t i = i0 + u * gthreads; if (i < n8) { a[u] = *(const GAS f32x4*)(src + i * 8); b[u] = *(const GAS f32x4*)(src + i * 8 + 4); } else { a[u] = (f32x4){0.f, 0.f, 0.f, 0.f}; b[u] = a[u]; } }
#pragma unroll
        for (int u = 0; u < 4; ++u) { const size_t i = i0 + u * gthreads; if (i < n8) { v4u o; o.x = pk2(a[u].x, a[u].y); o.y = pk2(a[u].z, a[u].w); o.z = pk2(b[u].x, b[u].y); o.w = pk2(b[u].z, b[u].w); *(GAS v4u*)(dst + i * 8) = o; } }
    }
}

constexpr int ATT_KS = 72, ATT_VS = 264;
constexpr int ATT_K_OFF = 0, ATT_V_OFF = 256 * ATT_KS * 2, ATT_B_OFF = ATT_V_OFF + 64 * ATT_VS * 2;
struct AttStage { v4u k[4], v0[2], v1[2]; float bias; };
__device__ __forceinline__ void attn_stage_load(AttStage& st, const bf16* KV, const float* RB, int b, int qb, int kvh, int tid) {
    const int s0 = qb * 128; const size_t tok0 = (size_t)b * SEQ + s0;
#pragma unroll
    for (int i = 0; i < 4; ++i) { const int id = tid + 512 * i, row = id >> 3, ch = id & 7; st.k[i] = (v4u){0u, 0u, 0u, 0u};
        if (s0 + row - 128 >= 0) st.k[i] = *(const GAS v4u*)(KV + (tok0 + row - 128) * 256 + kvh * 64 + ch * 8); }
#pragma unroll
    for (int i = 0; i < 2; ++i) { const int id = tid + 512 * i, kp = id & 127, ch = id >> 7; st.v0[i] = (v4u){0u, 0u, 0u, 0u}; st.v1[i] = st.v0[i];
        if (s0 + 2 * kp - 128 >= 0) { st.v0[i] = *(const GAS v4u*)(KV + (tok0 + 2 * kp - 128) * 256 + 128 + kvh * 64 + ch * 8); st.v1[i] = *(const GAS v4u*)(KV + (tok0 + 2 * kp + 1 - 128) * 256 + 128 + kvh * 64 + ch * 8); } }
    st.bias = RB[(kvh * 4 + (tid >> 7)) * 128 + (tid & 127)];
}
__device__ __forceinline__ void attn_unit(LAS unsigned char* lds, AttStage& st, const bf16* Q, const bf16* KV, bf16* AO, const float* RB, const float* sinks, int b, int qb, int kvh, bool has_next, int nb, int nqb, int nkvh, int tid) {
    const int lane = tid & 63, wid = __builtin_amdgcn_readfirstlane(tid >> 6), fr = lane & 15, fq = lane >> 4;
    const int s0 = qb * 128; const size_t tok0 = (size_t)b * SEQ + s0;
    LAS bf16* Ks = (LAS bf16*)(lds + ATT_K_OFF); LAS bf16* Vt = (LAS bf16*)(lds + ATT_V_OFF); LAS float* Bl = (LAS float*)(lds + ATT_B_OFF);
#pragma unroll
    for (int i = 0; i < 4; ++i) { const int id = tid + 512 * i, row = id >> 3, ch = id & 7; *(LAS v4u*)(Ks + row * ATT_KS + ch * 8) = st.k[i]; }
#pragma unroll
    for (int i = 0; i < 2; ++i) { const int id = tid + 512 * i, kp = id & 127, ch = id >> 7;
        const unsigned a0[4] = {st.v0[i].x, st.v0[i].y, st.v0[i].z, st.v0[i].w}, a1[4] = {st.v1[i].x, st.v1[i].y, st.v1[i].z, st.v1[i].w};
#pragma unroll
        for (int j = 0; j < 4; ++j) { const unsigned lo = (a0[j] & 0xffffu) | (a1[j] << 16), hi = (a0[j] >> 16) | (a1[j] & 0xffff0000u);
            *(LAS unsigned*)(Vt + (ch * 8 + 2 * j) * ATT_VS + 2 * kp) = lo; *(LAS unsigned*)(Vt + (ch * 8 + 2 * j + 1) * ATT_VS + 2 * kp) = hi; } }
    { const int hh = tid >> 7, d = tid & 127; Bl[hh * 176 + 16 + d] = st.bias; }
    LDS_WAIT(); __syncthreads();
    if (has_next) attn_stage_load(st, KV, RB, nb, nqb, nkvh, tid);
    const int hh = wid >> 1, head = kvh * 4 + hh; const float sink2 = sinks[head] * LOG2E;
    const LAS float* blp = Bl + hh * 176 + 16 + 128 + fr - 4 * fq;
#pragma unroll 1
    for (int it = 0; it < 4; ++it) {
        const int q0 = 64 * (wid & 1) + 16 * it, kt0 = q0 >> 4;
        const bf16* qp = Q + (tok0 + q0 + fr) * 512 + head * 64 + 8 * fq;
        const bf16x8 qf0 = *(const GAS bf16x8*)qp, qf1 = *(const GAS bf16x8*)(qp + 32);
        const float zz = pg8::opaque_f(0.f); const f32x4 zero4 = (f32x4){zz, zz, zz, zz};
        f32x4 st[9]; float mx = -3.0e38f;
#pragma unroll
        for (int t = 0; t < 9; ++t) {
            const LAS bf16* kp = Ks + (16 * (kt0 + t) + fr) * ATT_KS + 8 * fq;
            const bf16x8 k0 = *(const LAS bf16x8*)kp, k1 = *(const LAS bf16x8*)(kp + 32);
            f32x4 s = __builtin_amdgcn_mfma_f32_16x16x32_bf16(k0, qf0, zero4, 0, 0, 0);
            s = __builtin_amdgcn_mfma_f32_16x16x32_bf16(k1, qf1, s, 0, 0, 0);
            const bool tile_ok = (s0 + 16 * (kt0 + t) - 128 >= 0);
#pragma unroll
            for (int r = 0; r < 4; ++r) { const int dist = 128 + fr - 4 * fq - 16 * t - r; const float bv = blp[-16 * t - r];
                const bool ok = tile_ok && dist >= 0 && dist < 128; s[r] = ok ? s[r] + bv : -3.0e38f; mx = fmaxf(mx, s[r]); }
            st[t] = s;
        }
        mx = fmaxf(mx, pg8::shx(mx, 16, lane)); mx = fmaxf(mx, pg8::shx(mx, 32, lane)); mx = fmaxf(mx, sink2);
        float sum = 0.f;
#pragma unroll
        for (int t = 0; t < 9; ++t)
#pragma unroll
            for (int r = 0; r < 4; ++r) { const float p = __builtin_amdgcn_exp2f(st[t][r] - mx); st[t][r] = p; sum += p; }
        sum += pg8::shx(sum, 16, lane); sum += pg8::shx(sum, 32, lane);
        const float inv = 1.0f / (sum + __builtin_amdgcn_exp2f(sink2 - mx));
        f32x4 ot[4];
#pragma unroll
        for (int dt = 0; dt < 4; ++dt) ot[dt] = zero4;
#pragma unroll
        for (int k = 0; k < 5; ++k) {
            v4u pw; pw.x = pg8::cvt_pk_bf16(st[2 * k][0], st[2 * k][1]); pw.y = pg8::cvt_pk_bf16(st[2 * k][2], st[2 * k][3]);
            if (k < 4) { pw.z = pg8::cvt_pk_bf16(st[2 * k + 1][0], st[2 * k + 1][1]); pw.w = pg8::cvt_pk_bf16(st[2 * k + 1][2], st[2 * k + 1][3]); } else { pw.z = 0u; pw.w = 0u; }
            const bf16x8 pb = __builtin_bit_cast(bf16x8, pw);
#pragma unroll
            for (int dt = 0; dt < 4; ++dt) {
                const LAS bf16* vp = Vt + (16 * dt + fr) * ATT_VS + 16 * (kt0 + 2 * k) + 4 * fq;
                const v2u a = *(const LAS v2u*)vp; v2u c = (v2u){0u, 0u}; if (k < 4) c = *(const LAS v2u*)(vp + 16);
                const v4u av = (v4u){a.x, a.y, c.x, c.y};
                ot[dt] = __builtin_amdgcn_mfma_f32_16x16x32_bf16(__builtin_bit_cast(bf16x8, av), pb, ot[dt], 0, 0, 0);
            }
        }
        bf16* op = AO + (tok0 + q0 + fr) * 512 + head * 64 + 4 * fq;
#pragma unroll
        for (int dt = 0; dt < 4; ++dt) { v2u w; w.x = pg8::cvt_pk_bf16(ot[dt][0] * inv, ot[dt][1] * inv); w.y = pg8::cvt_pk_bf16(ot[dt][2] * inv, ot[dt][3] * inv); *(GAS v2u*)(op + 16 * dt) = w; }
    }
    __syncthreads();
}

__device__ __forceinline__ void scan_chain(const float* SL, bf16* UG, f32x2 aL, int g, int b, int lane) {
    const size_t row0 = (size_t)g * 2048 + b * 128;
    float xr = 0.f, xi = 0.f;
    float cr[8], ci[8], nr[8], ni[8];
#pragma unroll
    for (int k = 0; k < 8; ++k) { cr[k] = SL[(row0 + k) * 128 + lane]; ci[k] = SL[(row0 + k) * 128 + 64 + lane]; }
#pragma unroll 1
    for (int c0 = 0; c0 < NCHUNK; c0 += 8) {
        if (c0 + 8 < NCHUNK) {
#pragma unroll
            for (int k = 0; k < 8; ++k) { nr[k] = SL[(row0 + c0 + 8 + k) * 128 + lane]; ni[k] = SL[(row0 + c0 + 8 + k) * 128 + 64 + lane]; }
        }
#pragma unroll
        for (int k = 0; k < 8; ++k) {
            bf16* up = UG + (row0 + c0 + k) * UGLD + 256;
            up[lane] = (bf16)f2bf(xr); up[64 + lane] = (bf16)f2bf(xi);
            const float tr = aL.x * xr - aL.y * xi + cr[k], ti = aL.x * xi + aL.y * xr + ci[k]; xr = tr; xi = ti;
        }
#pragma unroll
        for (int k = 0; k < 8; ++k) { cr[k] = nr[k]; ci[k] = ni[k]; }
    }
}

struct RowRaw { v2u w[4]; };
__device__ __forceinline__ void row_load(RowRaw& r, const bf16* p, int lane) {
#pragma unroll
    for (int j = 0; j < 4; ++j) r.w[j] = *(const GAS v2u*)(p + 256 * j + 4 * lane);
}
__device__ __forceinline__ void row_unpack(f32x4 (&v)[4], const RowRaw& r) {
#pragma unroll
    for (int j = 0; j < 4; ++j) v[j] = (f32x4){pg8::bf_lo(r.w[j].x), pg8::bf_hi(r.w[j].x), pg8::bf_lo(r.w[j].y), pg8::bf_hi(r.w[j].y)};
}
__device__ __forceinline__ void route_row(const f32x4 (&v)[4], const LAS float* rt, int lane, int& e1, int& e2, float& g1, float& g2) {
    float s[8];
#pragma unroll
    for (int e = 0; e < 8; ++e) { float a = 0.f;
#pragma unroll
        for (int j = 0; j < 4; ++j) { const f32x4 w = *(const LAS f32x4*)(rt + e * DM + 256 * j + 4 * lane); a += (v[j].x * w.x + v[j].y * w.y) + (v[j].z * w.z + v[j].w * w.w); }
        s[e] = a; }
    const bool b5 = (lane & 32) != 0, b4 = (lane & 16) != 0, b3 = (lane & 8) != 0;
    float r[4], q[2];
#pragma unroll
    for (int i = 0; i < 4; ++i) { const float mine = b5 ? s[i + 4] : s[i], other = b5 ? s[i] : s[i + 4]; r[i] = mine + pg8::shx(other, 32, lane); }
#pragma unroll
    for (int i = 0; i < 2; ++i) { const float mine = b4 ? r[i + 2] : r[i], other = b4 ? r[i] : r[i + 2]; q[i] = mine + pg8::shx(other, 16, lane); }
    float w = (b3 ? q[1] : q[0]) + pg8::shx(b3 ? q[0] : q[1], 8, lane);
    w += pg8::shx(w, 4, lane); w += pg8::shx(w, 2, lane); w += pg8::shx(w, 1, lane);
    float lg[8];
#pragma unroll
    for (int e = 0; e < 8; ++e) lg[e] = __uint_as_float((unsigned)__builtin_amdgcn_readlane((int)__float_as_uint(w), 8 * e));
    e1 = 0; float v1 = lg[0];
#pragma unroll
    for (int e = 1; e < 8; ++e) if (lg[e] > v1) { v1 = lg[e]; e1 = e; }
    e2 = -1; float v2 = -3.0e38f;
#pragma unroll
    for (int e = 0; e < 8; ++e) if (e != e1 && lg[e] > v2) { v2 = lg[e]; e2 = e; }
    g1 = 1.0f / (1.0f + __expf(v2 - v1)); g2 = 1.0f - g1;
}
__device__ __forceinline__ void ln_load_bf16(f32x4 (&v)[4], const bf16* hrow, int lane) {
#pragma unroll
    for (int j = 0; j < 4; ++j) { const v2u w = *(const GAS v2u*)(hrow + 256 * j + 4 * lane); v[j] = (f32x4){pg8::bf_lo(w.x), pg8::bf_hi(w.x), pg8::bf_lo(w.y), pg8::bf_hi(w.y)}; }
}
__device__ __forceinline__ void ln_finish(f32x4 (&v)[4], const float* gam, const float* bet, float* outrow, bf16* xbrow, int lane) {
    float s = 0.f;
#pragma unroll
    for (int j = 0; j < 4; ++j) s += (v[j].x + v[j].y) + (v[j].z + v[j].w);
    const float mean = wave_sum(s, lane) * (1.f / DM); float s2 = 0.f;
#pragma unroll
    for (int j = 0; j < 4; ++j) { v[j] = v[j] - mean; s2 += (v[j].x * v[j].x + v[j].y * v[j].y) + (v[j].z * v[j].z + v[j].w * v[j].w); }
    const float rstd = 1.f / sqrtf(wave_sum(s2, lane) * (1.f / DM) + LN_EPS);
#pragma unroll
    for (int j = 0; j < 4; ++j) { const f32x4 gg = *(const GAS f32x4*)(gam + 256 * j + 4 * lane), bb = *(const GAS f32x4*)(bet + 256 * j + 4 * lane);
        v[j] = v[j] * rstd * gg + bb;
        if (outrow) *(GAS f32x4*)(outrow + 256 * j + 4 * lane) = v[j];
        v2u w; w.x = pk2(v[j].x, v[j].y); w.y = pk2(v[j].z, v[j].w); *(GAS v2u*)(xbrow + 256 * j + 4 * lane) = w; }
}

constexpr int NPH = 11;
__global__ void __launch_bounds__(NWAVES * 64, 2) fwd(Args args) {
    extern __shared__ __attribute__((aligned(16))) unsigned char lds_raw[];
    LAS unsigned char* lds = (LAS unsigned char*)lds_raw;
    volatile LAS unsigned* MISC = (volatile LAS unsigned*)(lds + MISC_OFF);
    const int G = gridDim.x, wave0 = __builtin_amdgcn_readfirstlane(threadIdx.x >> 6);
    { const int tid = threadIdx.x;
#define ctl WSP(unsigned, WS_CTL)
    for (int u = tid; u < (LDS_BYTES - LDSCTL_OFF) / 4; u += NWAVES * 64) ((LAS unsigned*)(lds + LDSCTL_OFF))[u] = 0u; }
    __syncthreads();
    XcdBarrier bar; bar.bar = (unsigned*)ctl + CW_BAR; bar.x = 0; bar.st = nullptr;
    if (!MK_PER_PHASE) bar = xcd_barrier_post((unsigned*)ctl + CW_BAR, MISC + 8, wave0 * 64 + pg8::lane_id());
    const int lo = args.ph_lo, hi = args.ph_hi;
#define IN(k) (lo <= (k) && (k) < hi)
#define SEAM(k) do { if (!MK_PER_PHASE && IN((k) + 1)) xcd_barrier(bar, wave0 * 64 + pg8::lane_id()); } while (0)
#define PHASE_IDS const int lane = pg8::lane_id(), wave = wave0, tid = wave * 64 + lane, bx = pg8::opaque_s(blockIdx.x), gw = bx * NWAVES + wave, NGW = G * NWAVES; (void)lane; (void)gw; (void)NGW

#define WIN WSP(bf16, WS_WIN)
#define WGLU WSP(bf16, WS_WGLU)
#define WBA WSP(bf16, WS_WBA)
#define WBS WSP(bf16, WS_WBS)
#define WOUT WSP(bf16, WS_WOUT)
#define WGU WSP(bf16, WS_WGU)
#define WDN WSP(bf16, WS_WDN)
#define MGU WSP(bf16, WS_MGU)
#define MDN WSP(bf16, WS_MDN)
#define PPJ WSP(bf16, WS_PPJ)
#define PGT WSP(bf16, WS_PGT)
#define SGm WSP(bf16, WS_SG)
#define TZE WSP(bf16, WS_TZE)
#define LAML WSP(f32x2, WS_MISC)
#define RB WSP(float, WS_MISC + 65536)
#define TOKE WSP(int, WS_MISC + 131072)
#define TOKG WSP(float, WS_MISC + 393216)
#define TOKP WSP(int, WS_MISC + 655360)
#define PB WSP(bf16, WS_PB)
#define XB WSP(bf16, WS_XB)
#define PP WSP(bf16, WS_PP)
#define XS WSP(bf16, WS_XS)
#define XIDX WSP(int, WS_XS + 256 * MiB)
#define Qb WSP(bf16, WS_Q)
#define KVb WSP(bf16, WS_KV)
#define UG WSP(bf16, WS_UG)
#define GAb WSP(bf16, WS_GA)
#define GSb WSP(bf16, WS_GS)
#define SL WSP(float, WS_SL)
#define AO WSP(bf16, WS_AO)
#define YB WSP(bf16, WS_YB)
#define SO WSP(bf16, WS_SO)
#define T1 WSP(bf16, WS_T1)
#define MG WSP(bf16, WS_MG)
#define HB WSP(bf16, WS_HB)
#define HBUF WSP(bf16, WS_HBUF)
#define R out_ptr()

    if (IN(0)) {
        PHASE_IDS; const size_t gtid = (size_t)bx * 512 + tid, gthreads = (size_t)G * 512;
        LAS float* scr = (LAS float*)(lds + RING_OFF + wave * 16384);
        for (int task = bx; task < DEPTH * 32; task += G) ssm_build(lds, task >> 5, task & 31, tid);
        if (bx == G - 1) { for (int i = tid; i < 8 * 128; i += 512) { const int h = i >> 7, d = i & 127; int bk = d;
                if (d >= 16) { bk = 16 + (int)(log((double)d / 16.0) / log(8.0) * 16.0); bk = bk > 31 ? 31 : bk; }
                RB[i] = in_ptr(I_RELB)[bk * 8 + h] * LOG2E; } }
        __syncthreads();
        {
            TrItem d0 = {nullptr, nullptr, 0, 0}; float r0[32];
#pragma unroll
            for (int i = 0; i < 32; ++i) r0[i] = 0.f;
            if (gw < TR_NIT) { tr_desc(d0, gw); tr_load(r0, d0, lane); }
#pragma unroll 1
            for (int it = gw; it < TR_NIT; it += NGW) {
                TrItem d1 = d0; float r1[32];
#pragma unroll
                for (int i = 0; i < 32; ++i) r1[i] = r0[i];
                if (it + NGW < TR_NIT) { tr_desc(d1, it + NGW); tr_load(r1, d1, lane); }
                tr_store(r0, d0, scr, lane);
                d0 = d1;
#pragma unroll
                for (int i = 0; i < 32; ++i) r0[i] = r1[i];
            }
        }
        cvt_rows(in_ptr(I_P), PB, (size_t)DEPTH * T * PLE / 8, gtid, gthreads);
        cvt_rows(in_ptr(I_X), XB, (size_t)T * DM / 8, gtid, gthreads);
        SEAM(0);
    }

#pragma unroll 1
    for (int l = 0; l < DEPTH; ++l) {
        const int P0 = 1 + l * NPH;
        const bool moe = (l & 1) != 0; const int l2 = l >> 1;
        if (IN(P0 + 0)) {
            PHASE_IDS;
            pg8::Gemm g{XB, WIN + (size_t)l * IN_COLS * 1024, 1024, 1024, 1024}; pg8::StaticOrder S; S.init(T, IN_COLS, G, bx);
            pg8::EpiInProj E{Qb, KVb, UG, GAb, GSb};
            pg8::gemm_phase<pg8::EpiInProj, pg8::StaticOrder, true, true>(lds + RING_OFF, g, S, E, tid);
            { pg8::Gemm g2{PB + (size_t)l * T * PLE, PPJ + (size_t)l * 1024 * PLE, PLE, PLE, pg8::opaque_s(PLE)}; pg8::StaticOrder S2; pg8::init_short(S2, T, 1024, G, bx, ((T / 256) * (IN_COLS / 256)) % G);
              pg8::EpiEw<0> E2{PP, 1024, nullptr, nullptr, nullptr};
              pg8::gemm_phase<pg8::EpiEw<0>, pg8::StaticOrder, true, true>(lds + RING_OFF, g2, S2, E2, tid); }
            SEAM(P0 + 0);
        }
        if (IN(P0 + 1)) {
            PHASE_IDS;
            { pg8::Gemm g{UG, SGm + (size_t)l * 32 * 256 * 256, UGLD, 256, 256}; pg8::GroupOrder S; S.init(UGROWS / 256, 3, G, bx);
              pg8::EpiS E{SL};
              pg8::gemm_phase<pg8::EpiS, pg8::GroupOrder, true, true>(lds + RING_OFF, g, S, E, tid); }
            SEAM(P0 + 1);
        }
        if (IN(P0 + 2)) {
            PHASE_IDS;
            if (wave < 2) { for (int ch = bx * 2 + wave; ch < 32 * BATCH; ch += 2 * G) { const int g = ch >> 4, b = ch & 15; scan_chain(SL, UG, LAML[(l * 32 + g) * 64 + lane], g, b, lane); } }
            { AttStage st = {}; const int NU = BATCH * 16 * 2;
              if (bx < NU) attn_stage_load(st, KVb, RB, bx >> 5, (bx >> 1) & 15, bx & 1, tid);
              for (int un = bx; un < NU; un += G) { const int kvh = un & 1, qb = (un >> 1) & 15, b = un >> 5, nu = un + G; const bool hn = nu < NU;
                attn_unit(lds + RING_OFF, st, Qb, KVb, AO, RB, in_ptr(I_SINKS) + l * 8, b, qb, kvh, hn, nu >> 5, (nu >> 1) & 15, nu & 1, tid); } }
            SEAM(P0 + 2);
        }
        if (IN(P0 + 3)) {
            PHASE_IDS;
            pg8::Gemm g{UG, TZE + (size_t)l * 32 * 256 * 384, UGLD, 384, 384}; pg8::GroupOrder S; S.init(UGROWS / 256, 3, G, bx);
            pg8::EpiY E{UG, in_ptr(I_SSMD) + l * 512, YB};
            pg8::gemm_phase<pg8::EpiY, pg8::GroupOrder, true, true>(lds + RING_OFF, g, S, E, tid);
            SEAM(P0 + 3);
        }
        if (IN(P0 + 4)) {
            PHASE_IDS;
            { pg8::Gemm g{YB, WGLU + (size_t)l * 512 * 512, 512, 512, 512}; pg8::StaticOrder S; S.init(T, 512, G, bx);
              pg8::EpiEw<1> E{SO, 512, YB, nullptr, in_ptr(I_BGLU) + l * 512};
              pg8::gemm_phase<pg8::EpiEw<1>, pg8::StaticOrder, true, true>(lds + RING_OFF, g, S, E, tid); }
            { pg8::Gemm g{AO, WBA + (size_t)l * 1024 * 512, 512, 512, 512}; pg8::StaticOrder S; S.init(T, 1024, G, bx);
              pg8::EpiEw<2> E{T1, 1024, GAb, nullptr, nullptr};
              pg8::gemm_phase<pg8::EpiEw<2>, pg8::StaticOrder, true, true>(lds + RING_OFF, g, S, E, tid); }
            SEAM(P0 + 4);
        }
        if (IN(P0 + 5)) {
            PHASE_IDS;
            pg8::Gemm g{SO, WBS + (size_t)l * 1024 * 512, 512, 512, 512}; pg8::StaticOrder S; S.init(T, 1024, G, bx);
            pg8::EpiEw<3> E{MG, 1024, GSb, T1, nullptr};
            pg8::gemm_phase<pg8::EpiEw<3>, pg8::StaticOrder, true, true>(lds + RING_OFF, g, S, E, tid);
            SEAM(P0 + 5);
        }
        if (IN(P0 + 6)) {
            PHASE_IDS;
            pg8::Gemm g{MG, WOUT + (size_t)l * 1024 * 1024, 1024, 1024, 1024}; pg8::StaticOrder S; S.init(T, 1024, G, bx);
            pg8::EpiEw<5> E{HBUF, 1024, XB, nullptr, nullptr};
            pg8::gemm_phase<pg8::EpiEw<5>, pg8::StaticOrder, true, true>(lds + RING_OFF, g, S, E, tid);
            SEAM(P0 + 6);
        }
        if (IN(P0 + 7)) {
            PHASE_IDS;
            const float* gam = in_ptr(I_LN1G) + l * DM; const float* bet = in_ptr(I_LN1B) + l * DM;
            LAS float* rt = (LAS float*)(lds + RING_OFF);
            if (moe) { const float* rw = in_ptr(I_ROUTER) + (size_t)l2 * DM * NEXP; for (int i = tid; i < DM * NEXP; i += 512) rt[(i & 7) * DM + (i >> 3)] = rw[i]; LDS_WAIT(); __syncthreads(); }
            unsigned* cur = (unsigned*)ctl + CW_MOE + (l2 * 16 + 8) * 64;
            for (int base = gw * 16; base < T; base += NGW * 16) {
                int ev = -1;
                RowRaw ca, cb; row_load(ca, HBUF + (size_t)base * DM, lane); row_load(cb, HBUF + (size_t)(base + 1) * DM, lane);
#pragma unroll 1
                for (int k = 0; k < 16; k += 2) { const int row = base + k;
                    RowRaw na = ca, nb = cb;
                    if (k + 2 < 16) { row_load(na, HBUF + (size_t)(row + 2) * DM, lane); row_load(nb, HBUF + (size_t)(row + 3) * DM, lane); }
                    f32x4 va[4], vb[4]; row_unpack(va, ca); row_unpack(vb, cb);
                    ln_finish(va, gam, bet, nullptr, XB + (size_t)row * DM, lane);
                    ln_finish(vb, gam, bet, nullptr, XB + (size_t)(row + 1) * DM, lane);
                    if (moe) {
                        int a1, a2, b1, b2; float ga1, ga2, gb1, gb2;
                        route_row(va, rt, lane, a1, a2, ga1, ga2); route_row(vb, rt, lane, b1, b2, gb1, gb2);
                        if (lane == 0) { TOKE[row * 2] = a1; TOKE[row * 2 + 1] = a2; TOKG[row * 2] = ga1; TOKG[row * 2 + 1] = ga2; TOKE[row * 2 + 2] = b1; TOKE[row * 2 + 3] = b2; TOKG[row * 2 + 2] = gb1; TOKG[row * 2 + 3] = gb2; }
                        if (lane == 2 * k) ev = a1; if (lane == 2 * k + 1) ev = a2; if (lane == 2 * k + 2) ev = b1; if (lane == 2 * k + 3) ev = b2;
                    }
                    ca = na; cb = nb;
                }
                if (moe) {
                    int rank = 0, mycnt = 0;
#pragma unroll
                    for (int x = 0; x < 8; ++x) { const unsigned long long mask = __ballot(ev == x); if (ev == x) rank = __popcll(mask & ((1ull << lane) - 1ull)); if (lane == x) mycnt = __popcll(mask); }
                    int old = 0; if (lane < 8 && mycnt) old = (int)xb_add(cur + lane * 64, (unsigned)mycnt);
                    const int pos = __builtin_amdgcn_ds_bpermute((ev < 0 ? 0 : ev) << 2, old) + rank;
                    if (lane < 32) { TOKP[base * 2 + lane] = pos; XIDX[(size_t)ev * T + pos] = base + (lane >> 1); }
                }
            }
            __syncthreads();
            SEAM(P0 + 7);
        }
        int tb1 = 0, tb2 = 0, tb3 = 0, tb4 = 0, tb5 = 0, tb6 = 0, tb7 = 0, NT = 0;
        if (moe && hi > P0 + 7) { unsigned* cw = (unsigned*)ctl + CW_MOE + (l2 * 16 + 8) * 64; int t = 0;
            t += ((int)xb_ld(cw + 0 * 64) + 255) >> 8; tb1 = t; t += ((int)xb_ld(cw + 1 * 64) + 255) >> 8; tb2 = t; t += ((int)xb_ld(cw + 2 * 64) + 255) >> 8; tb3 = t;
            t += ((int)xb_ld(cw + 3 * 64) + 255) >> 8; tb4 = t; t += ((int)xb_ld(cw + 4 * 64) + 255) >> 8; tb5 = t; t += ((int)xb_ld(cw + 5 * 64) + 255) >> 8; tb6 = t;
            t += ((int)xb_ld(cw + 6 * 64) + 255) >> 8; tb7 = t; t += ((int)xb_ld(cw + 7 * 64) + 255) >> 8; NT = t;
            tb1 = __builtin_amdgcn_readfirstlane(tb1); tb2 = __builtin_amdgcn_readfirstlane(tb2); tb3 = __builtin_amdgcn_readfirstlane(tb3); tb4 = __builtin_amdgcn_readfirstlane(tb4);
            tb5 = __builtin_amdgcn_readfirstlane(tb5); tb6 = __builtin_amdgcn_readfirstlane(tb6); tb7 = __builtin_amdgcn_readfirstlane(tb7); NT = __builtin_amdgcn_readfirstlane(NT); }
        if (IN(P0 + 8)) {
            PHASE_IDS;
            if (!moe) { pg8::Gemm g{XB, WGU + (size_t)l2 * 2 * DFF * 1024, 1024, 1024, 1024}; pg8::StaticOrder S; S.init(T, 2 * DFF, G, bx);
                pg8::EpiSwiGLU E{HB, DFF};
                pg8::gemm_phase<pg8::EpiSwiGLU, pg8::StaticOrder, true, true>(lds + RING_OFF, g, S, E, tid);
                { pg8::Gemm g2{XB, PGT + (size_t)l * 1024 * 1024, 1024, 1024, 1024}; pg8::StaticOrder S2; S2.init(T, 1024, G, bx);
                  pg8::EpiEw<4> E2{PP, 1024, nullptr, nullptr, nullptr};
                  pg8::gemm_phase<pg8::EpiEw<4>, pg8::StaticOrder, true, true>(lds + RING_OFF, g2, S2, E2, tid); } }
            else { pg8::Gemm g{XB, MGU + (size_t)l2 * NEXP * 2 * DFFE * 1024, 1024, 1024, 1024};
                pg8::MoeOrder S{NT, 2 * DFFE / 256, NT * (2 * DFFE / 256), G, bx, T / 256, tb1, tb2, tb3, tb4, tb5, tb6, tb7};
                pg8::EpiSwiGLU E{HB, DFFE};
                pg8::gemm_phase<pg8::EpiSwiGLU, pg8::MoeOrder, true, true, true>(lds + RING_OFF, g, S, E, tid, XIDX, T - 1); }
            SEAM(P0 + 8);
        }
        if (IN(P0 + 9)) {
            PHASE_IDS;
            if (!moe) { pg8::Gemm g{HB, WDN + (size_t)l2 * 1024 * DFF, DFF, DFF, DFF}; pg8::StaticOrder S; S.init(T, 1024, G, bx);
                pg8::EpiEw<6> E{HBUF, 1024, XB, PP, nullptr};
                pg8::gemm_phase<pg8::EpiEw<6>, pg8::StaticOrder, true, true>(lds + RING_OFF, g, S, E, tid); }
            else { pg8::Gemm g{HB, MDN + (size_t)l2 * NEXP * 1024 * DFFE, DFFE, DFFE, DFFE};
                pg8::MoeOrder S{NT, 4, NT * 4, G, bx, 0, tb1, tb2, tb3, tb4, tb5, tb6, tb7};
                pg8::EpiEw<0> E{XS, 1024, nullptr, nullptr, nullptr};
                pg8::gemm_phase<pg8::EpiEw<0>, pg8::MoeOrder, true, true>(lds + RING_OFF, g, S, E, tid);
                { pg8::Gemm g2{XB, PGT + (size_t)l * 1024 * 1024, 1024, 1024, 1024}; pg8::StaticOrder S2; pg8::init_short(S2, T, 1024, G, bx, (NT * 4) % G);
                  pg8::EpiEw<4> E2{PP, 1024, nullptr, nullptr, nullptr};
                  pg8::gemm_phase<pg8::EpiEw<4>, pg8::StaticOrder, true, true>(lds + RING_OFF, g2, S2, E2, tid); } }
            SEAM(P0 + 9);
        }
        if (IN(P0 + 10)) {
            PHASE_IDS;
            const float* gam = in_ptr(I_LN2G) + l * DM; const float* bet = in_ptr(I_LN2B) + l * DM;
            for (int base = gw * 16; base < T; base += NGW * 16) {
                int tp = 0; float tg = 0.f;
                if (moe && lane < 32) { const int te = TOKE[base * 2 + lane]; tg = TOKG[base * 2 + lane];
                    tp = TOKP[base * 2 + lane] + 256 * (te == 0 ? 0 : te == 1 ? tb1 : te == 2 ? tb2 : te == 3 ? tb3 : te == 4 ? tb4 : te == 5 ? tb5 : te == 6 ? tb6 : tb7); }
                const bf16* xsrc = moe ? XB : HBUF;
                RowRaw cx[2] = {}, cy[2][2] = {}, cp[2] = {};
#define LN2_LOAD(dx, dy, dp, r0) do { _Pragma("unroll") for (int q_ = 0; q_ < 2; ++q_) { const int row_ = (r0) + q_; row_load(dx[q_], xsrc + (size_t)row_ * DM, lane); \
                    if (moe) { const int kk_ = row_ - base; const int p1_ = __builtin_amdgcn_readlane(tp, 2 * kk_), p2_ = __builtin_amdgcn_readlane(tp, 2 * kk_ + 1); \
                        row_load(dy[q_][0], XS + (size_t)p1_ * DM, lane); row_load(dy[q_][1], XS + (size_t)p2_ * DM, lane); row_load(dp[q_], PP + (size_t)row_ * DM, lane); } } } while (0)
                LN2_LOAD(cx, cy, cp, base);
#pragma unroll 1
                for (int k = 0; k < 16; k += 2) { const int row = base + k;
                    RowRaw nx[2], ny[2][2], np[2];
#pragma unroll
                    for (int q = 0; q < 2; ++q) { nx[q] = cx[q]; np[q] = cp[q]; ny[q][0] = cy[q][0]; ny[q][1] = cy[q][1]; }
                    if (k + 2 < 16) LN2_LOAD(nx, ny, np, row + 2);
#pragma unroll
                    for (int q = 0; q < 2; ++q) { f32x4 v[4]; row_unpack(v, cx[q]);
                        if (moe) { f32x4 fa[4], fb[4], fc[4]; row_unpack(fa, cy[q][0]); row_unpack(fb, cy[q][1]); row_unpack(fc, cp[q]);
                            const float g1 = __uint_as_float((unsigned)__builtin_amdgcn_readlane((int)__float_as_uint(tg), 2 * (k + q))), g2 = __uint_as_float((unsigned)__builtin_amdgcn_readlane((int)__float_as_uint(tg), 2 * (k + q) + 1));
#pragma unroll
                            for (int j = 0; j < 4; ++j) v[j] = v[j] * ALPHA + fa[j] * g1 + fb[j] * g2 + fc[j]; }
                        ln_finish(v, gam, bet, l + 1 < DEPTH ? nullptr : R + (size_t)(row + q) * DM, XB + (size_t)(row + q) * DM, lane); }
#pragma unroll
                    for (int q = 0; q < 2; ++q) { cx[q] = nx[q]; cp[q] = np[q]; cy[q][0] = ny[q][0]; cy[q][1] = ny[q][1]; }
                }
#undef LN2_LOAD
            }
            SEAM(P0 + 10);
        }
    }
#undef IN
#undef SEAM
}

extern "C" void kernel_launch(void* const* d_in, const int* in_sizes, int n_in, void* d_out, int out_size, void* d_ws, size_t ws_size, hipStream_t stream) {
    static int grid = 0;
    if (grid == 0) {
        if (n_in != 29 || out_size != T * DM || ws_size < WS_END) { fprintf(stderr, "kernel_launch: unexpected shapes (n_in %d, out %d, ws %zu, need %zu)\n", n_in, out_size, ws_size, (size_t)WS_END); grid = -1; return; }
        int dev = 0, cus = 0, per_cu = 0;
        if (hipGetDevice(&dev) != hipSuccess || hipDeviceGetAttribute(&cus, hipDeviceAttributeMultiprocessorCount, dev) != hipSuccess) { grid = -1; return; }
        if (hipFuncSetAttribute((const void*)fwd, hipFuncAttributeMaxDynamicSharedMemorySize, LDS_BYTES) != hipSuccess) { fprintf(stderr, "kernel_launch: hipFuncSetAttribute failed\n"); grid = -1; return; }
        if (hipOccupancyMaxActiveBlocksPerMultiprocessor(&per_cu, (const void*)fwd, NWAVES * 64, LDS_BYTES) != hipSuccess || per_cu < 1) fprintf(stderr, "kernel_launch: occupancy query reports %d\n", per_cu);
        (void)hipGetLastError();
        grid = cus;
    }
    if (grid < 0) return;
    if (hipMemsetAsync((char*)d_ws + WS_CTL, 0, CTL_ZERO_BYTES, stream) != hipSuccess) { fprintf(stderr, "kernel_launch: memset failed\n"); return; }
    Args a{};
    for (int i = 0; i < 29; ++i) a.in[i] = (const float*)d_in[i];
    a.out = (float*)d_out; a.ws = (unsigned char*)d_ws;
    const int NPHASES = 1 + DEPTH * NPH;
#if MK_PER_PHASE
    for (int ph = 0; ph < NPHASES; ++ph) { a.ph_lo = ph; a.ph_hi = ph + 1; hipLaunchKernelGGL(fwd, dim3(grid), dim3(NWAVES * 64), LDS_BYTES, stream, a); }
#else
    a.ph_lo = 0; a.ph_hi = NPHASES;
    hipLaunchKernelGGL(fwd, dim3(grid), dim3(NWAVES * 64), LDS_BYTES, stream, a);
#endif
    const hipError_t le = hipPeekAtLastError();
    if (le != hipSuccess) fprintf(stderr, "kernel_launch: launch failed: %s\n", hipGetErrorName(le));
}
```

```cpp
#include <hip/hip_runtime.h>
#include <cstdio>
#include <cstdint>

#ifndef MK_PER_PHASE
#define MK_PER_PHASE 0
#endif

namespace pg8 {
#define PG8_LAS __attribute__((address_space(3)))
typedef unsigned short bf16_t;
typedef short bf16x8 __attribute__((ext_vector_type(8)));
typedef float f32x4 __attribute__((ext_vector_type(4)));
typedef unsigned u32x4 __attribute__((ext_vector_type(4)));
typedef unsigned u32x2 __attribute__((ext_vector_type(2)));
__device__ __forceinline__ int opaque_v(int x) { asm volatile("" : "+v"(x)); return x; }
__device__ __forceinline__ int lane_id() { int l; asm volatile("v_mbcnt_lo_u32_b32 %0, -1, 0\n\tv_mbcnt_hi_u32_b32 %0, -1, %0" : "=v"(l)); return l; }
__device__ __forceinline__ float shx(float v, int o, int lane) { return __uint_as_float((unsigned)__builtin_amdgcn_ds_bpermute((lane ^ o) << 2, (int)__float_as_uint(v))); }
__device__ __forceinline__ float opaque_f(float x) { asm volatile("" : "+v"(x)); return x; }
__device__ __forceinline__ int opaque_s(int x) { asm volatile("" : "+s"(x)); return x; }
constexpr int BM = 256, BK = 64, HALF = 128, HTB = HALF * BK * 2, STAGE_BYTES = 8 * HTB, NXCD = 8, WGM = 4;

__host__ __device__ __forceinline__ int lds_byte(int r, int c) { const int st = (r >> 4) * 2 + (c >> 5), rr = r & 15, cc = c & 31, ob = rr * 64 + cc * 2; return st * 1024 + (ob ^ (((ob >> 9) & 1) << 5)); }
__host__ __device__ __forceinline__ void stage_rc(int b, int& R, int& C) { const int st = b / 1024, sb = b % 1024, swz = sb ^ (((sb >> 9) & 1) << 5); R = (st >> 1) * 16 + swz / 64; C = (st & 1) * 32 + (swz % 64) / 2; }
__host__ __device__ __forceinline__ int perm32(int rho) { const int n = rho >> 4, i = rho & 15; return 8 * (i >> 2) + 4 * n + (i & 3); }

struct Unit { int pm, pn, pc, pa; };
struct Gemm { const bf16_t* A; const bf16_t* Bt; int lda, ldb, K; };

struct StaticOrder {
    int nM, nN, nwg, G, c;
    __device__ void init(int M, int N, int G_, int c_) { nM = M / BM; nN = N / BM; nwg = nM * nN; G = G_; c = c_; }
    __device__ bool next(int i, Unit& u) const {
        const long L = (long)i * G + c; if (L >= nwg) return false;
        int wgid = (int)L; { const int q = nwg / NXCD, r = nwg % NXCD, xcd = wgid % NXCD, off = wgid / NXCD; wgid = (xcd < r ? xcd * (q + 1) : r * (q + 1) + (xcd - r) * q) + off; }
        const int nig = WGM * nN, gid = wgid / nig, fm = gid * WGM, gsz = (nM - fm) < WGM ? (nM - fm) : WGM;
        u.pm = fm + ((wgid % nig) % gsz); u.pn = (wgid % nig) / gsz; u.pc = u.pn; u.pa = u.pm; return true;
    }
    __device__ __forceinline__ void a_ready(const Unit&) const {}
    __device__ __forceinline__ void done(const Unit&) const {}
};
__device__ __forceinline__ void init_short(StaticOrder& S, int M, int N, int G, int c, int rem) {
    const int ns = rem == 0 ? G : G - rem; int cs = c - rem; if (cs < 0) cs += G;
    S.init(M, N, ns, cs < ns ? cs : (1 << 28));
}
struct GroupOrder {
    int nM, G, c, shift;
    __device__ void init(int nM_, int shift_, int G_, int c_) { nM = nM_; shift = shift_; G = G_; c = c_; }
    __device__ bool next(int i, Unit& u) const {
        const long L = (long)i * G + c; if (L >= nM) return false;
        int wgid = (int)L; { const int q = nM / NXCD, r = nM % NXCD, xcd = wgid % NXCD, off = wgid / NXCD; wgid = (xcd < r ? xcd * (q + 1) : r * (q + 1) + (xcd - r) * q) + off; }
        u.pm = wgid; u.pn = wgid >> shift; u.pc = 0; u.pa = wgid; return true;
    }
    __device__ __forceinline__ void a_ready(const Unit&) const {}
    __device__ __forceinline__ void done(const Unit&) const {}
};
struct MoeOrder {
    int nM, nN, nwg, G, c, acap, t1, t2, t3, t4, t5, t6, t7;
    __device__ bool next(int i, Unit& u) const {
        const long L = (long)i * G + c; if (L >= nwg) return false;
        int wgid = (int)L; { const int q = nwg / NXCD, r = nwg % NXCD, xcd = wgid % NXCD, off = wgid / NXCD; wgid = (xcd < r ? xcd * (q + 1) : r * (q + 1) + (xcd - r) * q) + off; }
        const int nig = WGM * nN, gid = wgid / nig, fm = gid * WGM, gsz = (nM - fm) < WGM ? (nM - fm) : WGM;
        u.pm = fm + ((wgid % nig) % gsz); u.pc = (wgid % nig) / gsz;
        const int e = (u.pm >= t1) + (u.pm >= t2) + (u.pm >= t3) + (u.pm >= t4) + (u.pm >= t5) + (u.pm >= t6) + (u.pm >= t7);
        int be = 0; be = u.pm >= t1 ? t1 : be; be = u.pm >= t2 ? t2 : be; be = u.pm >= t3 ? t3 : be; be = u.pm >= t4 ? t4 : be; be = u.pm >= t5 ? t5 : be; be = u.pm >= t6 ? t6 : be; be = u.pm >= t7 ? t7 : be;
        u.pn = e * nN + u.pc; u.pa = acap ? e * acap + (u.pm - be) : u.pm; return true;
    }
    __device__ __forceinline__ void a_ready(const Unit&) const {}
    __device__ __forceinline__ void done(const Unit&) const {}
};

typedef float f32x2_cv __attribute__((ext_vector_type(2))); typedef __bf16 bf16x2_cv __attribute__((ext_vector_type(2)));
__device__ __forceinline__ unsigned cvt_pk_bf16(float lo, float hi) { const f32x2_cv v = {lo, hi}; return __builtin_bit_cast(unsigned, __builtin_convertvector(v, bf16x2_cv)); }
__device__ __forceinline__ float bf_lo(unsigned w) { return __uint_as_float(w << 16); }
__device__ __forceinline__ float bf_hi(unsigned w) { return __uint_as_float(w & 0xffff0000u); }
__device__ __forceinline__ float sigm(float x) { return __builtin_amdgcn_rcpf(1.0f + __builtin_amdgcn_exp2f(-1.4426950408889634f * x)); }
__device__ __forceinline__ float gelu_tanh(float x) { const float t = x + 0.044715f * x * x * x; return x * __builtin_amdgcn_rcpf(1.0f + __builtin_amdgcn_exp2f(-2.302208198f * t)); }
__device__ __forceinline__ u32x4 pack8(const f32x4& a, const f32x4& b) { u32x4 w; w.x = cvt_pk_bf16(a[0], a[1]); w.y = cvt_pk_bf16(a[2], a[3]); w.z = cvt_pk_bf16(b[0], b[1]); w.w = cvt_pk_bf16(b[2], b[3]); return w; }
__device__ __forceinline__ void unpack8(const u32x4& w, f32x4& a, f32x4& b) { a = (f32x4){bf_lo(w.x), bf_hi(w.x), bf_lo(w.y), bf_hi(w.y)}; b = (f32x4){bf_lo(w.z), bf_hi(w.z), bf_lo(w.w), bf_hi(w.w)}; }

__device__ __forceinline__ void unpack8_u8(const u32x2& w, f32x4& a, f32x4& b) { const float k = 1.0f / 255.0f;
    a = (f32x4){(float)(w.x & 0xffu), (float)((w.x >> 8) & 0xffu), (float)((w.x >> 16) & 0xffu), (float)(w.x >> 24)} * k; b = (f32x4){(float)(w.y & 0xffu), (float)((w.y >> 8) & 0xffu), (float)((w.y >> 16) & 0xffu), (float)(w.y >> 24)} * k; }
#define PG8_FOR_AM _Pragma("unroll") for (int ai = 0; ai < 2; ++ai) _Pragma("unroll") for (int m = 0; m < 4; ++m)
#define PG8_FOR_BJ _Pragma("unroll") for (int bj = 0; bj < 2; ++bj)

struct EpiInProj {
    static constexpr bool PERM = true, AFTER_DRAIN = false;
    bf16_t *Q, *KV, *UG, *GA, *GS;
    __device__ __forceinline__ void operator()(const f32x4 (&acc)[2][2][4][2], const Unit& u, int wr, int wc, int fr, int fq) const {
        const int row0 = u.pm * BM + wr * 64 + fr, cl = wc * 32 + 8 * fq, pc = u.pc;
        if (pc < 3) {
            bf16_t* base = pc < 2 ? Q + pc * 256 : KV; const int ld = pc < 2 ? 512 : 256; const float sc = pc < 2 ? 0.125f * 1.4426950408889634f : 1.0f;
            PG8_FOR_AM { bf16_t* rp = base + (size_t)(row0 + ai * HALF + m * 16) * ld + cl;
                PG8_FOR_BJ { *(u32x4*)(rp + bj * HALF) = pack8(acc[ai][bj][m][0] * sc, acc[ai][bj][m][1] * sc); } }
        } else if (pc < 5) {
            PG8_FOR_AM { const int row = row0 + ai * HALF + m * 16, b = row >> 11, s = row & 2047, c = s >> 4, i = s & 15;
                PG8_FOR_BJ { const int ch = (pc - 3) * 256 + bj * HALF + cl, g = ch >> 4, h0 = ch & 15;
                    *(u32x4*)(UG + (size_t)(g * 2048 + b * 128 + c) * 384 + i * 16 + h0) = pack8(acc[ai][bj][m][0], acc[ai][bj][m][1]); } }
        } else {
            unsigned char* base = (unsigned char*)(pc < 9 ? GA : GS) + (pc < 9 ? pc - 5 : pc - 9) * 256;
            PG8_FOR_AM { unsigned char* rp = base + (size_t)(row0 + ai * HALF + m * 16) * 1024 + cl;
                PG8_FOR_BJ { const f32x4 a = acc[ai][bj][m][0], b = acc[ai][bj][m][1]; unsigned q[8];
#pragma unroll
                    for (int k = 0; k < 4; ++k) { q[k] = (unsigned)(sigm(a[k]) * 255.f + 0.5f); q[4 + k] = (unsigned)(sigm(b[k]) * 255.f + 0.5f); }
                    u32x2 w; w.x = q[0] | (q[1] << 8) | (q[2] << 16) | (q[3] << 24); w.y = q[4] | (q[5] << 8) | (q[6] << 16) | (q[7] << 24);
                    *(u32x2*)(rp + bj * HALF) = w; } }
        }
    }
};
struct EpiS {
    static constexpr bool PERM = false, AFTER_DRAIN = false;
    float* SL;
    __device__ __forceinline__ void operator()(const f32x4 (&acc)[2][2][4][2], const Unit& u, int wr, int wc, int fr, int fq) const {
        const int row0 = u.pm * BM + wr * 64 + fr, c0 = wc * 32 + 4 * fq;
        PG8_FOR_AM { float* rp = SL + (size_t)(row0 + ai * HALF + m * 16) * 128 + c0;
#pragma unroll
            for (int n = 0; n < 2; ++n) *(f32x4*)(rp + n * 16) = acc[ai][0][m][n]; }
    }
};
#define PG8_GROUP_FENCE asm volatile("" ::: "memory")
struct EpiY {
    static constexpr bool PERM = true, AFTER_DRAIN = false;
    const bf16_t* UG; const float* Dv; bf16_t* YB;
    __device__ __forceinline__ void operator()(const f32x4 (&acc)[2][2][4][2], const Unit& u, int wr, int wc, int fr, int fq) const {
        constexpr int AHEAD = 3;
        const int row0 = u.pm * BM + wr * 64 + fr, cl = wc * 32 + 8 * fq, g = (u.pm * BM) >> 11, h0 = cl & 15, ch = g * 16 + h0;
        const f32x4 d0 = *(const f32x4*)(Dv + ch), d1 = *(const f32x4*)(Dv + ch + 4);
        u32x4 ub[AHEAD + 1][2];
#define EPIY_LOAD(gi) do { const int row_ = row0 + ((gi) >> 2) * HALF + ((gi) & 3) * 16; _Pragma("unroll") for (int bj = 0; bj < 2; ++bj) ub[(gi) % (AHEAD + 1)][bj] = *(const u32x4*)(UG + (size_t)row_ * 384 + bj * HALF + cl); } while (0)
#pragma unroll
        for (int gi = 0; gi < AHEAD; ++gi) EPIY_LOAD(gi);
#pragma unroll
        for (int gi = 0; gi < 8; ++gi) { const int ai = gi >> 2, m = gi & 3;
            if (gi + AHEAD < 8) EPIY_LOAD(gi + AHEAD);
            PG8_GROUP_FENCE;
            const int row = row0 + ai * HALF + m * 16, b = (row >> 7) & 15, c = row & 127;
            PG8_FOR_BJ { const int col = bj * HALF + cl, j = col >> 4; const size_t t = (size_t)b * 2048 + c * 16 + j;
                f32x4 u0, u1; unpack8(ub[gi % (AHEAD + 1)][bj], u0, u1);
                f32x4 a = acc[ai][bj][m][0] + d0 * u0, bb = acc[ai][bj][m][1] + d1 * u1;
#pragma unroll
                for (int k = 0; k < 4; ++k) { a[k] = gelu_tanh(a[k]); bb[k] = gelu_tanh(bb[k]); }
                *(u32x4*)(YB + t * 512 + ch) = pack8(a, bb); } }
#undef EPIY_LOAD
    }
};
template <int MODE> struct EpiEw {
    static constexpr bool PERM = true, AFTER_DRAIN = false;
    bf16_t* O; int ld; const bf16_t* X; const bf16_t* Y; const float* bias;
    __device__ __forceinline__ void operator()(const f32x4 (&acc)[2][2][4][2], const Unit& u, int wr, int wc, int fr, int fq) const {
        constexpr int AHEAD = MODE == 0 ? 0 : ((MODE == 3 || MODE == 6) ? 2 : 3), NB = AHEAD + 1; constexpr bool HASY = (MODE == 3 || MODE == 6); constexpr float AL = 1.681792830507429f;
        const int row0 = u.pm * BM + wr * 64 + fr, col0 = u.pc * BM + wc * 32 + 8 * fq;
        const bf16_t* Xp = MODE == 4 ? O : X;
        constexpr bool X8 = (MODE == 2 || MODE == 3);
        u32x4 xb[X8 ? 1 : NB][2], yb[HASY ? NB : 1][2]; u32x2 xg[X8 ? NB : 1][2];
        f32x4 bv[2][2];
        if (MODE == 1) { PG8_FOR_BJ { bv[bj][0] = *(const f32x4*)(bias + col0 + bj * HALF); bv[bj][1] = *(const f32x4*)(bias + col0 + bj * HALF + 4); } }
#define EPIEW_LOAD(gi) do { const size_t ro_ = (size_t)(row0 + ((gi) >> 2) * HALF + ((gi) & 3) * 16) * ld + col0; _Pragma("unroll") for (int bj = 0; bj < 2; ++bj) { \
            if (X8) xg[(gi) % NB][bj] = *(const u32x2*)((const unsigned char*)Xp + ro_ + bj * HALF); else xb[(gi) % NB][bj] = *(const u32x4*)(Xp + ro_ + bj * HALF); \
            if (HASY) yb[(gi) % NB][bj] = *(const u32x4*)(Y + ro_ + bj * HALF); } } while (0)
        if (MODE != 0) {
#pragma unroll
            for (int gi = 0; gi < AHEAD; ++gi) EPIEW_LOAD(gi);
        }
#pragma unroll
        for (int gi = 0; gi < 8; ++gi) { const int ai = gi >> 2, m = gi & 3;
            if (MODE != 0) { if (gi + AHEAD < 8) EPIEW_LOAD(gi + AHEAD); PG8_GROUP_FENCE; }
            const size_t ro = (size_t)(row0 + ai * HALF + m * 16) * ld + col0;
            PG8_FOR_BJ { const size_t off = ro + bj * HALF; f32x4 a = acc[ai][bj][m][0], b = acc[ai][bj][m][1];
                if (MODE == 1) { f32x4 y0, y1; unpack8(xb[gi % NB][bj], y0, y1); a += bv[bj][0]; b += bv[bj][1];
#pragma unroll
                    for (int k = 0; k < 4; ++k) { a[k] = y0[k] * sigm(a[k]); b[k] = y1[k] * sigm(b[k]); } }
                if (MODE == 2) { f32x4 x0, x1; unpack8_u8(xg[gi % NB][bj], x0, x1); a *= x0; b *= x1; }
                if (MODE == 3) { f32x4 x0, x1, y0, y1; unpack8_u8(xg[gi % NB][bj], x0, x1); unpack8(yb[gi % NB][bj], y0, y1); a = y0 + x0 * a; b = y1 + x1 * b; }
                if (MODE == 5) { f32x4 x0, x1; unpack8(xb[gi % NB][bj], x0, x1); a += x0 * AL; b += x1 * AL; }
                if (MODE == 6) { f32x4 x0, x1, y0, y1; unpack8(xb[gi % NB][bj], x0, x1); unpack8(yb[gi % NB][bj], y0, y1); a += x0 * AL + y0; b += x1 * AL + y1; }
                if (MODE == 4) { f32x4 y0, y1; unpack8(xb[gi % NB][bj], y0, y1);
#pragma unroll
                    for (int k = 0; k < 4; ++k) { a[k] = y0[k] * sigm(a[k]); b[k] = y1[k] * sigm(b[k]); } }
                *(u32x4*)(O + off) = pack8(a, b); } }
#undef EPIEW_LOAD
    }
};
struct EpiSwiGLU {
    static constexpr bool PERM = true, AFTER_DRAIN = false;
    bf16_t* H; int ld;
    __device__ __forceinline__ void operator()(const f32x4 (&acc)[2][2][4][2], const Unit& u, int wr, int wc, int fr, int fq) const {
        const int row0 = u.pm * BM + wr * 64 + fr, col0 = u.pc * HALF + wc * 32 + 8 * fq;
        PG8_FOR_AM { f32x4 a = acc[ai][0][m][0], b = acc[ai][0][m][1]; const f32x4 ua = acc[ai][1][m][0], ub = acc[ai][1][m][1];
#pragma unroll
            for (int k = 0; k < 4; ++k) { a[k] = a[k] * sigm(a[k]) * ua[k]; b[k] = b[k] * sigm(b[k]) * ub[k]; }
            *(u32x4*)(H + (size_t)(row0 + ai * HALF + m * 16) * ld + col0) = pack8(a, b); }
    }
};

template <class Epi, class Sched, bool ALIGN_EPI = false, bool SP2 = false, bool GATHER = false>
__device__ __forceinline__ void gemm_phase(PG8_LAS unsigned char* lds, const Gemm g, const Sched& S, const Epi& E, const int tid_in, const int* gidx = nullptr, const int gmax = 0) {
    static_assert(!GATHER || SP2, "the gather path is written for the SP2 loop");
    const int tid = opaque_v(tid_in);
    const int wid = __builtin_amdgcn_readfirstlane(tid >> 6), lane = tid & 63, wr = wid >> 2, wc = wid & 3, fr = lane & 15, fq = lane >> 4;
    const int K = g.K, nt = K / BK;
    unsigned voffA[2], voffB[2]; int gR[2], gC2[2];
#pragma unroll
    for (int i = 0; i < 2; ++i) { int R, C; stage_rc(tid * 16 + i * 8192, R, C); const int Rb = Epi::PERM ? ((R & ~31) + perm32(R & 31)) : R;
        voffA[i] = (unsigned)(R * g.lda + C) * 2u; voffB[i] = (unsigned)(Rb * g.ldb + C) * 2u; gR[i] = R; gC2[i] = C * 2; }
    unsigned vC0[2], vC1[2];
#define PG8_GDMA(slot, pa_) do { if (wid < 4) __builtin_amdgcn_global_load_lds((const unsigned*)(gidx + (size_t)(pa_) * BM + wid * 64 + lane), (PG8_LAS unsigned*)(lds + STAGE_BYTES + 2048 + (slot) * 1024 + wid * 256), 4, 0, 0); } while (0)
#define PG8_GREAD(d0, d1, slot) do { const PG8_LAS unsigned* ix_ = (const PG8_LAS unsigned*)(lds + STAGE_BYTES + 2048 + (slot) * 1024); _Pragma("unroll") for (int _i = 0; _i < 2; ++_i) { \
        unsigned r0_ = ix_[gR[_i]], r1_ = ix_[HALF + gR[_i]]; r0_ = r0_ > (unsigned)gmax ? (unsigned)gmax : r0_; r1_ = r1_ > (unsigned)gmax ? (unsigned)gmax : r1_; \
        d0[_i] = r0_ * (unsigned)(g.lda * 2) + (unsigned)gC2[_i]; d1[_i] = r1_ * (unsigned)(g.lda * 2) + (unsigned)gC2[_i]; } } while (0)
    const size_t kstep = (size_t)(BK * 2);
    const size_t hstepA = (size_t)HALF * g.lda * 2, hstepB = (size_t)HALF * g.ldb * 2;
    const size_t tstepA = 2 * hstepA, tstepB = 2 * hstepB;
    const unsigned ldsw = (unsigned)wid * 1024u;
    const int aoff = lds_byte(wr * 64 + fr, fq * 8), boff = lds_byte(wc * 32 + fr, fq * 8);
#define PG8_SA(b, h) (((b) * 2 + (h)) * HTB)
#define PG8_SB(b, h) ((4 + (b) * 2 + (h)) * HTB)
#define PG8_STAGE(bufoff, gbase, voff) do { _Pragma("unroll") for (int _i = 0; _i < 2; ++_i) \
        __builtin_amdgcn_global_load_lds((const unsigned*)((const char*)(gbase) + (voff)[_i]), (PG8_LAS unsigned*)(lds + (bufoff) + ldsw + _i * 8192), 16, 0, 0); } while (0)
#define PG8_LDA(dst, b, h) do { _Pragma("unroll") for (int m = 0; m < 4; ++m) _Pragma("unroll") for (int k = 0; k < 2; ++k) dst[m][k] = *(const PG8_LAS bf16x8*)(lds + PG8_SA(b, h) + aoff + m * 2048 + k * 1024); } while (0)
#define PG8_LDB(dst, b, h) do { _Pragma("unroll") for (int n = 0; n < 2; ++n) _Pragma("unroll") for (int k = 0; k < 2; ++k) dst[n][k] = *(const PG8_LAS bf16x8*)(lds + PG8_SB(b, h) + boff + n * 2048 + k * 1024); } while (0)
#define PG8_MMA(ai, bj, At, Bt) do { __builtin_amdgcn_s_setprio(1); _Pragma("unroll") for (int m = 0; m < 4; ++m) _Pragma("unroll") for (int n = 0; n < 2; ++n) _Pragma("unroll") for (int k = 0; k < 2; ++k) \
        acc[ai][bj][m][n] = __builtin_amdgcn_mfma_f32_16x16x32_bf16(Bt[n][k], At[m][k], acc[ai][bj][m][n], 0, 0, 0); __builtin_amdgcn_s_setprio(0); } while (0)
#define PG8_WAIT_V(n) asm volatile("s_waitcnt vmcnt(" #n ")" ::: "memory")
#define PG8_WAIT_L(n) asm volatile("s_waitcnt lgkmcnt(" #n ")" ::: "memory")
#define PG8_BAR __builtin_amdgcn_s_barrier()
#define PG8_SCHED __builtin_amdgcn_sched_barrier(0)
    Unit cur, nxt; int ui = 0;
    if (!S.next(0, cur)) return;
    const float zz = opaque_f(0.f);
    f32x4 acc[2][2][4][2];
#pragma unroll
    for (int a = 0; a < 2; ++a)
#pragma unroll
        for (int b = 0; b < 2; ++b)
#pragma unroll
            for (int m = 0; m < 4; ++m)
#pragma unroll
                for (int n = 0; n < 2; ++n) acc[a][b][m][n] = (f32x4){zz, zz, zz, zz};
    bf16x8 At[4][2], B0[2][2], B1[2][2];
    const char* cA = GATHER ? (const char*)g.A : (const char*)g.A + (size_t)cur.pa * tstepA; const char* cB = (const char*)g.Bt + (size_t)cur.pn * tstepB;
    S.a_ready(cur);
    if constexpr (GATHER) { PG8_GDMA(0, cur.pa); PG8_WAIT_V(0); PG8_BAR; PG8_GREAD(vC0, vC1, 0); }
    if constexpr (SP2) {
        PG8_STAGE(PG8_SB(0, 0), cB, voffB); PG8_STAGE(PG8_SB(0, 1), cB + hstepB, voffB);
        if constexpr (GATHER) { PG8_STAGE(PG8_SA(0, 0), cA, vC0); PG8_STAGE(PG8_SA(0, 1), cA, vC1); } else { PG8_STAGE(PG8_SA(0, 0), cA, voffA); PG8_STAGE(PG8_SA(0, 1), cA + hstepA, voffA); }
        if (wr == 1) PG8_BAR;
        PG8_WAIT_V(2); PG8_BAR;
        PG8_STAGE(PG8_SB(1, 0), cB + kstep, voffB); if constexpr (GATHER) PG8_STAGE(PG8_SA(1, 0), cA + kstep, vC0); else PG8_STAGE(PG8_SA(1, 0), cA + kstep, voffA); PG8_STAGE(PG8_SB(1, 1), cB + hstepB + kstep, voffB);
        PG8_WAIT_V(6); PG8_BAR;
    } else {
        PG8_STAGE(PG8_SB(0, 0), cB, voffB); PG8_STAGE(PG8_SA(0, 0), cA, voffA); PG8_STAGE(PG8_SB(0, 1), cB + hstepB, voffB); PG8_STAGE(PG8_SA(0, 1), cA + hstepA, voffA);
        if (wr == 1) PG8_BAR;
        PG8_WAIT_V(4); PG8_BAR;
        PG8_STAGE(PG8_SB(1, 0), cB + kstep, voffB); PG8_STAGE(PG8_SA(1, 0), cA + kstep, voffA); PG8_STAGE(PG8_SB(1, 1), cB + hstepB + kstep, voffB);
        PG8_WAIT_V(6); PG8_BAR;
    }
    for (;;) {
        const bool has_next = S.next(ui + 1, nxt);
        const char* nA = GATHER ? cA : (has_next ? (const char*)g.A + (size_t)nxt.pa * tstepA : cA); const char* nB = has_next ? (const char*)g.Bt + (size_t)nxt.pn * tstepB : cB;
        if constexpr (GATHER) { if (has_next) PG8_GDMA((ui + 1) & 1, nxt.pa); }
        for (int t = 0; t < nt; t += 2) {
            const bool last = (t == nt - 2);
            const char* a1 = cA + (size_t)(t + 1) * kstep;
            const char* a2 = last ? nA : cA + (size_t)(t + 2) * kstep; const char* b2 = last ? nB : cB + (size_t)(t + 2) * kstep;
            const char* a3 = a2 + kstep; const char* b3 = b2 + kstep;
            if (last && has_next) S.a_ready(nxt);
            if constexpr (SP2) {
            unsigned w0[2], w1[2];
            if constexpr (GATHER) { _Pragma("unroll") for (int i = 0; i < 2; ++i) { w0[i] = vC0[i]; w1[i] = vC1[i]; } if (last && has_next) PG8_GREAD(w0, w1, (ui + 1) & 1); }
            PG8_LDB(B0, 0, 0); PG8_LDB(B1, 0, 1); PG8_SCHED; PG8_LDA(At, 0, 0); if constexpr (GATHER) PG8_STAGE(PG8_SA(1, 1), a1, vC1); else PG8_STAGE(PG8_SA(1, 1), a1 + hstepA, voffA);
            PG8_WAIT_V(8); PG8_WAIT_L(0); PG8_BAR; PG8_MMA(0, 0, At, B0); PG8_MMA(0, 1, At, B1); PG8_BAR; PG8_SCHED;
            PG8_LDA(At, 0, 1); PG8_STAGE(PG8_SB(0, 0), b2, voffB); PG8_STAGE(PG8_SB(0, 1), b2 + hstepB, voffB); if constexpr (GATHER) PG8_STAGE(PG8_SA(0, 0), a2, w0); else PG8_STAGE(PG8_SA(0, 0), a2, voffA);
            PG8_WAIT_V(8); PG8_WAIT_L(0); PG8_BAR; PG8_MMA(1, 0, At, B0); PG8_MMA(1, 1, At, B1); PG8_BAR; PG8_SCHED;
            PG8_LDB(B0, 1, 0); PG8_LDB(B1, 1, 1); PG8_SCHED; PG8_LDA(At, 1, 0); if constexpr (GATHER) PG8_STAGE(PG8_SA(0, 1), a2, w1); else PG8_STAGE(PG8_SA(0, 1), a2 + hstepA, voffA);
            PG8_WAIT_V(8); PG8_WAIT_L(0); PG8_BAR; PG8_MMA(0, 0, At, B0); PG8_MMA(0, 1, At, B1); PG8_BAR; PG8_SCHED;
            PG8_LDA(At, 1, 1); PG8_STAGE(PG8_SB(1, 0), b3, voffB); PG8_STAGE(PG8_SB(1, 1), b3 + hstepB, voffB); if constexpr (GATHER) PG8_STAGE(PG8_SA(1, 0), a3, w0); else PG8_STAGE(PG8_SA(1, 0), a3, voffA);
            PG8_WAIT_V(8); PG8_WAIT_L(0); PG8_BAR; PG8_MMA(1, 0, At, B0); PG8_MMA(1, 1, At, B1); PG8_BAR; PG8_SCHED;
            } else {
            PG8_LDB(B0, 0, 0); PG8_SCHED; PG8_LDA(At, 0, 0); PG8_STAGE(PG8_SA(1, 1), a1 + hstepA, voffA);
            PG8_WAIT_L(8); PG8_BAR; PG8_WAIT_L(0); PG8_MMA(0, 0, At, B0); PG8_BAR; PG8_SCHED;
            PG8_LDB(B1, 0, 1); PG8_STAGE(PG8_SB(0, 0), b2, voffB);
            PG8_BAR; PG8_WAIT_L(0); PG8_MMA(0, 1, At, B1); PG8_BAR;
            PG8_LDA(At, 0, 1); PG8_STAGE(PG8_SA(0, 0), a2, voffA);
            PG8_BAR; PG8_WAIT_L(0); PG8_MMA(1, 0, At, B0); PG8_BAR; PG8_SCHED;
            PG8_STAGE(PG8_SB(0, 1), b2 + hstepB, voffB);
            PG8_WAIT_V(6); PG8_BAR; PG8_MMA(1, 1, At, B1); PG8_BAR;
            PG8_LDB(B0, 1, 0); PG8_SCHED; PG8_LDA(At, 1, 0); PG8_STAGE(PG8_SA(0, 1), a2 + hstepA, voffA);
            PG8_WAIT_L(8); PG8_BAR; PG8_WAIT_L(0); PG8_MMA(0, 0, At, B0); PG8_BAR; PG8_SCHED;
            PG8_LDB(B1, 1, 1); PG8_STAGE(PG8_SB(1, 0), b3, voffB);
            PG8_BAR; PG8_WAIT_L(0); PG8_MMA(0, 1, At, B1); PG8_BAR;
            PG8_LDA(At, 1, 1); PG8_STAGE(PG8_SA(1, 0), a3, voffA);
            PG8_BAR; PG8_WAIT_L(0); PG8_MMA(1, 0, At, B0); PG8_BAR; PG8_SCHED;
            PG8_STAGE(PG8_SB(1, 1), b3 + hstepB, voffB);
            PG8_WAIT_V(6); PG8_BAR; PG8_MMA(1, 1, At, B1); PG8_BAR;
            }
        }
        if constexpr (ALIGN_EPI) { if (wr == 0) PG8_BAR; }
        if constexpr (!Epi::AFTER_DRAIN) { const int l2_ = lane_id(); E(acc, cur, wr, wc, l2_ & 15, l2_ >> 4); S.done(cur); }
        if (!has_next) break;
#pragma unroll
        for (int a = 0; a < 2; ++a)
#pragma unroll
            for (int b = 0; b < 2; ++b)
#pragma unroll
                for (int m = 0; m < 4; ++m)
#pragma unroll
                    for (int n = 0; n < 2; ++n) acc[a][b][m][n] = (f32x4){zz, zz, zz, zz};
        cur = nxt; cA = nA; cB = nB; ++ui;
        if constexpr (GATHER) PG8_GREAD(vC0, vC1, ui & 1);
        if constexpr (ALIGN_EPI) { if (wr == 1) PG8_BAR; }
    }
    PG8_WAIT_V(0);
    if constexpr (!ALIGN_EPI) { if (wr == 0) PG8_BAR; }
    PG8_BAR;
#undef PG8_GDMA
#undef PG8_GREAD
#undef PG8_SA
#undef PG8_SB
#undef PG8_STAGE
#undef PG8_LDA
#undef PG8_LDB
#undef PG8_MMA
#undef PG8_WAIT_V
#undef PG8_WAIT_L
#undef PG8_BAR
#undef PG8_SCHED
}
}

constexpr int NWAVES = 8;
constexpr int DM = 1024, BATCH = 16, SEQ = 2048, T = BATCH * SEQ, DEPTH = 4;
constexpr int IN_COLS = 3328, DFF = 2816, DFFE = 3584, NEXP = 8, PLE = 256;
constexpr int CH = 16;
constexpr int NCHUNK = SEQ / CH;
constexpr int UGROWS = 32 * BATCH * NCHUNK;
constexpr int UGLD = 384;
constexpr int XSROWS = 2 * T + NEXP * 256;
constexpr float LN_EPS = 1e-5f;
constexpr float ALPHA = 1.681792830507429f;
constexpr float LOG2E = 1.4426950408889634f;

constexpr size_t MiB = 1u << 20;
constexpr size_t WS_CTL = 0, CTL_ZERO_BYTES = 1 * MiB;
constexpr size_t WS_WIN = 1 * MiB;
constexpr size_t WS_WGLU = WS_WIN + 26 * MiB;
constexpr size_t WS_WBA = WS_WGLU + 2 * MiB;
constexpr size_t WS_WBS = WS_WBA + 4 * MiB;
constexpr size_t WS_WOUT = WS_WBS + 4 * MiB;
constexpr size_t WS_WGU = WS_WOUT + 8 * MiB;
constexpr size_t WS_WDN = WS_WGU + 22 * MiB;
constexpr size_t WS_MGU = WS_WDN + 11 * MiB;
constexpr size_t WS_MDN = WS_MGU + 224 * MiB;
constexpr size_t WS_PPJ = WS_MDN + 112 * MiB;
constexpr size_t WS_PGT = WS_PPJ + 2 * MiB;
constexpr size_t WS_SG = WS_PGT + 8 * MiB;
constexpr size_t WS_TZE = WS_SG + 16 * MiB;
constexpr size_t WS_MISC = WS_TZE + 24 * MiB;
constexpr size_t WS_PB = WS_MISC + 2 * MiB;
constexpr size_t WS_XB = WS_PB + 64 * MiB;
constexpr size_t WS_PP = WS_XB + 64 * MiB;
constexpr size_t WS_XS = WS_PP + 64 * MiB;
constexpr size_t WS_MIX = WS_XS + 512 * MiB;
constexpr size_t WS_Q = WS_MIX;
constexpr size_t WS_KV = WS_Q + 32 * MiB;
constexpr size_t WS_UG = WS_KV + 16 * MiB;
constexpr size_t WS_GA = WS_UG + 48 * MiB;
constexpr size_t WS_GS = WS_GA + 64 * MiB;
constexpr size_t WS_SL = WS_GS + 64 * MiB;
constexpr size_t WS_AO = WS_SL + 32 * MiB;
constexpr size_t WS_YB = WS_AO + 32 * MiB;
constexpr size_t WS_SO = WS_YB + 32 * MiB;
constexpr size_t WS_T1 = WS_SO + 32 * MiB;
constexpr size_t WS_MG = WS_T1 + 64 * MiB;
constexpr size_t WS_HB = WS_MIX;
constexpr size_t WS_HBUF = WS_MIX + 480 * MiB;
constexpr size_t WS_END = WS_HBUF + 64 * MiB;
static_assert(WS_MG + 64 * MiB == WS_HBUF && (size_t)XSROWS * DFFE * 2 <= 480 * MiB && (size_t)XSROWS * DM * 2 <= 512 * MiB, "d_ws map");

constexpr int CW_BAR = 4096;
constexpr int CW_MOE = 16384;

constexpr int RING_OFF = 0, RING_BYTES = 131072;
constexpr int LDSCTL_OFF = RING_BYTES, MISC_OFF = LDSCTL_OFF + 320;
constexpr int LDS_BYTES = 147456;

#define GAS __attribute__((address_space(1)))
#define LAS __attribute__((address_space(3)))
typedef unsigned short bf16;
typedef unsigned v4u __attribute__((ext_vector_type(4)));
typedef unsigned v2u __attribute__((ext_vector_type(2)));
typedef float f32x4 __attribute__((ext_vector_type(4)));
typedef float f32x2 __attribute__((ext_vector_type(2)));
typedef short bf16x8 __attribute__((ext_vector_type(8)));
typedef short bf16x4 __attribute__((ext_vector_type(4)));
typedef GAS unsigned gu32;
#define RLX_AGENT __ATOMIC_RELAXED, __HIP_MEMORY_SCOPE_AGENT
#define LDS_WAIT() asm volatile("s_waitcnt lgkmcnt(0)" ::: "memory")
#define VM_WAIT() asm volatile("s_waitcnt vmcnt(0)" ::: "memory")
__device__ __forceinline__ unsigned f2bf(float f) { unsigned u = __builtin_bit_cast(unsigned, f); return (u + 0x7fffu + ((u >> 16) & 1u)) >> 16; }
__device__ __forceinline__ unsigned pk2(float lo, float hi) { return f2bf(lo) | (f2bf(hi) << 16); }

#define XB_TMO      128
#define XB_XCNT(j)  (256  + 64 * (j))
#define XB_XSUB(j)  (1280 + 64 * (j))
#define XB_XGEN(j)  (2304 + 64 * (j))
#define XB_TOP      3328
#define XB_TOPGEN   3392
#define XCD_BAR_WORDS 3456
#define XB_SPIN_CAP (1u << 18)

__device__ __forceinline__ unsigned xb_ld(unsigned* p)              { return __hip_atomic_load(p, __ATOMIC_RELAXED, __HIP_MEMORY_SCOPE_AGENT); }
__device__ __forceinline__ unsigned xb_add(unsigned* p, unsigned v) { return __hip_atomic_fetch_add(p, v, __ATOMIC_RELAXED, __HIP_MEMORY_SCOPE_AGENT); }
__device__ __forceinline__ unsigned xb_xcc_id() { return (unsigned)__builtin_amdgcn_s_getreg((3 << 11) | 20) & 0xFu; }
#define XB_SPIN(cond, bar) do { unsigned _sp = 0; while (cond) { __builtin_amdgcn_s_sleep(1); \
    if ((++_sp & 255u) == 0u) { if (xb_ld(&(bar)[XB_TMO])) break; if (_sp > XB_SPIN_CAP) { atomicAdd(&(bar)[XB_TMO], 1u); break; } } } } while (0)

struct XcdBarrier { unsigned* bar; unsigned x; volatile LAS unsigned* st; };

__device__ __forceinline__ XcdBarrier xcd_barrier_post(unsigned* bar, volatile LAS unsigned* st, int tid) {
    XcdBarrier b; b.bar = bar; b.x = xb_xcc_id(); b.st = st;
    if (tid == 0) (void)xb_add(&bar[XB_XCNT(b.x)], 1u);
    return b;
}
__device__ __forceinline__ void xcd_barrier_complete(unsigned* bar, unsigned x, unsigned& nloc, unsigned& nx) {
    const unsigned G = gridDim.x * gridDim.y * gridDim.z;
    unsigned sum, cnt, mine, sp = 0u;
    for (;;) {
        sum = 0u; cnt = 0u; mine = 0u;
#pragma unroll 1
        for (unsigned j = 0; j < 16; ++j) { const unsigned c = xb_ld(&bar[XB_XCNT(j)]); sum += c; cnt += (c > 0u) ? 1u : 0u; mine = (j == x) ? c : mine; }
        if (sum == G) break;
        __builtin_amdgcn_s_sleep(1);
        if ((++sp & 255u) == 0u) { if (xb_ld(&bar[XB_TMO])) break; if (sp > XB_SPIN_CAP) { atomicAdd(&bar[XB_TMO], 1u); break; } }
    }
    nloc = mine > 0u ? mine : 1u; nx = cnt > 0u ? cnt : 1u;
}
__device__ __forceinline__ void xcd_barrier(const XcdBarrier& b, int tid) {
    asm volatile("s_waitcnt vmcnt(0)" ::: "memory");
    __syncthreads();
    if (tid == 0) {
        unsigned* bar = b.bar; asm volatile("" : "+s"(bar));
        __builtin_amdgcn_s_waitcnt(0);
        unsigned nloc = b.st[0], nx = b.st[1];
        if (nloc == 0u) { xcd_barrier_complete(bar, b.x, nloc, nx); b.st[0] = nloc; b.st[1] = nx; }
        const unsigned old = xb_add(&bar[XB_XSUB(b.x)], 1u);
        const unsigned gen = old / nloc;
        if (old + 1u == (gen + 1u) * nloc) {
            __builtin_amdgcn_fence(__ATOMIC_RELEASE, "agent");
            asm volatile("s_waitcnt vmcnt(0)" ::: "memory");
            const unsigned og = xb_add(&bar[XB_TOP], 1u);
            const unsigned tg = og / nx;
            if (og + 1u == (tg + 1u) * nx) xb_add(&bar[XB_TOPGEN], 1u);
            else XB_SPIN(xb_ld(&bar[XB_TOPGEN]) == tg, bar);
            __builtin_amdgcn_fence(__ATOMIC_ACQUIRE, "agent");
            xb_add(&bar[XB_XGEN(b.x)], 1u);
            asm volatile("s_waitcnt vmcnt(0)" ::: "memory");
        } else {
            XB_SPIN(xb_ld(&bar[XB_XGEN(b.x)]) == gen, bar);
            __builtin_amdgcn_fence(__ATOMIC_ACQUIRE, "agent");
            asm volatile("s_waitcnt vmcnt(0)" ::: "memory");
        }
    }
    __syncthreads();
}

struct Args { const float* in[29]; float* out; unsigned char* ws; int ph_lo, ph_hi; };
enum { I_X = 0, I_P, I_RELB, I_WIN, I_SINKS, I_LRE, I_LIM, I_LOGDT, I_BRE, I_BIM, I_CRE, I_CIM, I_SSMD, I_WGLU, I_BGLU, I_WBA, I_WBS, I_WOUT, I_LN1G, I_LN1B,
       I_FGU, I_FDN, I_ROUTER, I_MGU, I_MDN, I_PPROJ, I_PGATE, I_LN2G, I_LN2B };

typedef const __attribute__((address_space(4))) unsigned char* kptr_t;
__device__ __forceinline__ kptr_t karg_base() { kptr_t k = (kptr_t)__builtin_amdgcn_kernarg_segment_ptr(); asm volatile("" : "+s"(k)); return k; }
__device__ __forceinline__ const float* in_ptr(int i) { return *(const float* const __attribute__((address_space(4)))*)(karg_base() + 8 * i); }
__device__ __forceinline__ float* out_ptr() { return *(float* const __attribute__((address_space(4)))*)(karg_base() + 8 * 29); }
__device__ __forceinline__ unsigned char* ws_ptr() { return *(unsigned char* const __attribute__((address_space(4)))*)(karg_base() + 8 * 30); }
static_assert(sizeof(Args) == 8 * 31 + 8, "Args layout");
#define WSP(T, off) ((T*)(ws_ptr() + (off)))

__device__ __forceinline__ float wave_sum(float v, int lane) {
#pragma unroll
    for (int o = 1; o < 64; o <<= 1) v += pg8::shx(v, o, lane);
    return v;
}

struct TrItem { const float* src; bf16* dst; int N, K; };
__device__ __forceinline__ void tr_desc1(TrItem& d, const float* W, int K, int N, bf16* WT, int ilv, int item) {
    const int nblk = N / 32, kb = item / nblk, nb = item % nblk, k0 = 64 * kb, n0 = 32 * nb;
    int r0 = n0;
    if (ilv > 0) { r0 = n0 < ilv ? (n0 / 128) * 256 + (n0 % 128) : ((n0 - ilv) / 128) * 256 + 128 + ((n0 - ilv) % 128); }
    d.src = W + (size_t)k0 * N + n0; d.dst = WT + (size_t)r0 * K + k0; d.N = N; d.K = K;
}
__device__ __forceinline__ bool tr_family(int& r, TrItem& d, const float* W, int nb, int K, int N, bf16* WT, int ilv) {
    const int per = (K / 64) * (N / 32), tot = nb * per;
    if (r < tot) { const int mi = r / per; tr_desc1(d, W + (size_t)mi * K * N, K, N, WT + (size_t)mi * K * N, ilv, r % per); return true; }
    r -= tot; return false;
}
constexpr int TR_NIT = 4 * 16 * 104 + 4 * 8 * 16 + 2 * (4 * 8 * 32) + 4 * 16 * 32 + 2 * 16 * 176 + 2 * 44 * 32 + 16 * 16 * 224 + 16 * 56 * 32 + 4 * 4 * 32 + 4 * 16 * 32;
__device__ __forceinline__ void tr_desc(TrItem& d, int it) {
    int r = it;
    if (tr_family(r, d, in_ptr(I_WIN), 4, 1024, 3328, WSP(bf16, WS_WIN), 0)) return;
    if (tr_family(r, d, in_ptr(I_WGLU), 4, 512, 512, WSP(bf16, WS_WGLU), 0)) return;
    if (tr_family(r, d, in_ptr(I_WBA), 4, 512, 1024, WSP(bf16, WS_WBA), 0)) return;
    if (tr_family(r, d, in_ptr(I_WBS), 4, 512, 1024, WSP(bf16, WS_WBS), 0)) return;
    if (tr_family(r, d, in_ptr(I_WOUT), 4, 1024, 1024, WSP(bf16, WS_WOUT), 0)) return;
    if (tr_family(r, d, in_ptr(I_FGU), 2, 1024, 2 * 2816, WSP(bf16, WS_WGU), 2816)) return;
    if (tr_family(r, d, in_ptr(I_FDN), 2, 2816, 1024, WSP(bf16, WS_WDN), 0)) return;
    if (tr_family(r, d, in_ptr(I_MGU), 16, 1024, 2 * 3584, WSP(bf16, WS_MGU), 3584)) return;
    if (tr_family(r, d, in_ptr(I_MDN), 16, 3584, 1024, WSP(bf16, WS_MDN), 0)) return;
    if (tr_family(r, d, in_ptr(I_PPROJ), 4, 256, 1024, WSP(bf16, WS_PPJ), 0)) return;
    tr_family(r, d, in_ptr(I_PGATE), 4, 1024, 1024, WSP(bf16, WS_PGT), 0);
}
__device__ __forceinline__ void tr_load(float (&v)[32], const TrItem& d, int lane) {
    const float* p = d.src + (size_t)(lane >> 5) * d.N + (lane & 31);
#pragma unroll
    for (int i = 0; i < 32; ++i) v[i] = *(const GAS float*)(p + (size_t)(2 * i) * d.N);
}
__device__ __forceinline__ void tr_store(const float (&v)[32], const TrItem& d, LAS float* scr, int lane) {
#pragma unroll
    for (int i = 0; i < 32; ++i) scr[(2 * i + (lane >> 5)) * 33 + (lane & 31)] = v[i];
    LDS_WAIT(); asm volatile("" ::: "memory");
    const int c = lane & 7;
#pragma unroll
    for (int j = 0; j < 4; ++j) { const int n = (lane >> 3) + 8 * j; const LAS float* s = scr + (8 * c) * 33 + n;
        v4u o; o.x = pk2(s[0 * 33], s[1 * 33]); o.y = pk2(s[2 * 33], s[3 * 33]); o.z = pk2(s[4 * 33], s[5 * 33]); o.w = pk2(s[6 * 33], s[7 * 33]);
        *(GAS v4u*)(d.dst + (size_t)n * d.K + 8 * c) = o; }
    LDS_WAIT(); asm volatile("" ::: "memory");
}

__device__ __forceinline__ void ssm_build(LAS unsigned char* lds, int l, int g, int tid) {
    unsigned char* ws = ws_ptr();
    LAS f32x2* lamd = (LAS f32x2*)lds;
    LAS f32x2* bbar = lamd + 17 * 64;
    LAS f32x2* cc = bbar + 64 * 16;
    LAS float* Kt = (LAS float*)(cc + 16 * 64);
    const int lg = l * 32 + g;
    if (tid < 64) {
        const int p = tid; const double lr = in_ptr(I_LRE)[lg * 64 + p], li = in_ptr(I_LIM)[lg * 64 + p], dt = exp((double)in_ptr(I_LOGDT)[lg]);
        for (int d = 0; d <= 16; ++d) { const double mag = exp(d * lr * dt), ang = d * li * dt; lamd[d * 64 + p] = (f32x2){(float)(mag * cos(ang)), (float)(mag * sin(ang))}; }
        const double m1 = exp(lr * dt), br = m1 * cos(li * dt) - 1.0, bi = m1 * sin(li * dt), den = lr * lr + li * li;
        const double cr = (br * lr + bi * li) / den, ci = (bi * lr - br * li) / den;
        for (int h = 0; h < 16; ++h) { const double xr = in_ptr(I_BRE)[(lg * 64 + p) * 16 + h], xi = in_ptr(I_BIM)[(lg * 64 + p) * 16 + h];
            bbar[p * 16 + h] = (f32x2){(float)(cr * xr - ci * xi), (float)(cr * xi + ci * xr)}; }
        const double mL = exp(16 * lr * dt), aL = 16 * li * dt;
        ((f32x2*)(ws + WS_MISC))[lg * 64 + p] = (f32x2){(float)(mL * cos(aL)), (float)(mL * sin(aL))};
    }
    for (int i = tid; i < 1024; i += 512) { const int h = i >> 6, p = i & 63; cc[i] = (f32x2){in_ptr(I_CRE)[(lg * 16 + h) * 64 + p], in_ptr(I_CIM)[(lg * 16 + h) * 64 + p]}; }
    __syncthreads();
    for (int o = tid; o < 4096; o += 512) { const int d = o >> 8, h = (o >> 4) & 15, h2 = o & 15; float s = 0.f;
        for (int p = 0; p < 64; ++p) { const f32x2 c = cc[h * 64 + p], lm = lamd[d * 64 + p], b = bbar[p * 16 + h2];
            const float tr = c.x * lm.x - c.y * lm.y, ti = c.x * lm.y + c.y * lm.x; s += tr * b.x - ti * b.y; }
        Kt[o] = s; }
    __syncthreads();
    bf16* SG = (bf16*)(ws + WS_SG) + (size_t)lg * 256 * 256;
    for (int ck = tid; ck < 256 * 32; ck += 512) { const int n = ck >> 5, k0 = (ck & 31) * 8, i = k0 >> 4, h0 = k0 & 15; float v[8];
#pragma unroll
        for (int j = 0; j < 8; ++j) { if (n < 128) { const int p = n & 63; const f32x2 lm = lamd[(15 - i) * 64 + p], b = bbar[p * 16 + h0 + j];
                v[j] = n < 64 ? lm.x * b.x - lm.y * b.y : lm.x * b.y + lm.y * b.x; } else v[j] = 0.f; }
        v4u o; o.x = pk2(v[0], v[1]); o.y = pk2(v[2], v[3]); o.z = pk2(v[4], v[5]); o.w = pk2(v[6], v[7]);
        *(GAS v4u*)(SG + (size_t)n * 256 + k0) = o; }
    bf16* TZ = (bf16*)(ws + WS_TZE) + (size_t)lg * 256 * 384;
    for (int ck = tid; ck < 256 * 48; ck += 512) { const int n = ck / 48, k0 = (ck % 48) * 8, j = n >> 4, h = n & 15; float v[8];
#pragma unroll
        for (int q = 0; q < 8; ++q) { const int k = k0 + q;
            if (k < 256) { const int i = k >> 4, h2 = k & 15; v[q] = i <= j ? Kt[((j - i) * 16 + h) * 16 + h2] : 0.f; }
            else { const int p = (k - 256) & 63; const f32x2 c = cc[h * 64 + p], lm = lamd[(j + 1) * 64 + p];
                v[q] = k < 320 ? c.x * lm.x - c.y * lm.y : -(c.x * lm.y + c.y * lm.x); } }
        v4u o; o.x = pk2(v[0], v[1]); o.y = pk2(v[2], v[3]); o.z = pk2(v[4], v[5]); o.w = pk2(v[6], v[7]);
        *(GAS v4u*)(TZ + (size_t)n * 384 + k0) = o; }
    __syncthreads();
}

__device__ __forceinline__ void cvt_rows(const float* src, bf16* dst, size_t n8, size_t gtid, size_t gthreads) {
    for (size_t i0 = gtid; i0 < n8; i0 += 4 * gthreads) {
        f32x4 a[4], b[4];
#pragma unroll
        for (int u = 0; u < 4; ++u) { const size_t i = i0 + u * gthreads; if (i < n8) { a[u] = *(const GAS f32x4*)(src + i * 8); b[u] = *(const GAS f32x4*)(src + i * 8 + 4); } else { a[u] = (f32x4){0.f, 0.f, 0.f, 0.f}; b[u] = a[u]; } }
#pragma unroll
        for (int u = 0; u < 4; ++u) { const size_t i = i0 + u * gthreads; if (i < n8) { v4u o; o.x = pk2(a[u].x, a[u].y); o.y = pk2(a[u].z, a[u].w); o.z = pk2(b[u].x, b[u].y); o.w = pk2(b[u].z, b[u].w); *(GAS v4u*)(dst + i * 8) = o; } }
    }
}

constexpr int ATT_KS = 72, ATT_VS = 264;
constexpr int ATT_K_OFF = 0, ATT_V_OFF = 256 * ATT_KS * 2, ATT_B_OFF = ATT_V_OFF + 64 * ATT_VS * 2;
struct AttStage { v4u k[4], v0[2], v1[2]; float bias; };
__device__ __forceinline__ void attn_stage_load(AttStage& st, const bf16* KV, const float* RB, int b, int qb, int kvh, int tid) {
    const int s0 = qb * 128; const size_t tok0 = (size_t)b * SEQ + s0;
#pragma unroll
    for (int i = 0; i < 4; ++i) { const int id = tid + 512 * i, row = id >> 3, ch = id & 7; st.k[i] = (v4u){0u, 0u, 0u, 0u};
        if (s0 + row - 128 >= 0) st.k[i] = *(const GAS v4u*)(KV + (tok0 + row - 128) * 256 + kvh * 64 + ch * 8); }
#pragma unroll
    for (int i = 0; i < 2; ++i) { const int id = tid + 512 * i, kp = id & 127, ch = id >> 7; st.v0[i] = (v4u){0u, 0u, 0u, 0u}; st.v1[i] = st.v0[i];
        if (s0 + 2 * kp - 128 >= 0) { st.v0[i] = *(const GAS v4u*)(KV + (tok0 + 2 * kp - 128) * 256 + 128 + kvh * 64 + ch * 8); st.v1[i] = *(const GAS v4u*)(KV + (tok0 + 2 * kp + 1 - 128) * 256 + 128 + kvh * 64 + ch * 8); } }
    st.bias = RB[(kvh * 4 + (tid >> 7)) * 128 + (tid & 127)];
}
__device__ __forceinline__ void attn_unit(LAS unsigned char* lds, AttStage& st, const bf16* Q, const bf16* KV, bf16* AO, const float* RB, const float* sinks, int b, int qb, int kvh, bool has_next, int nb, int nqb, int nkvh, int tid) {
    const int lane = tid & 63, wid = __builtin_amdgcn_readfirstlane(tid >> 6), fr = lane & 15, fq = lane >> 4;
    const int s0 = qb * 128; const size_t tok0 = (size_t)b * SEQ + s0;
    LAS bf16* Ks = (LAS bf16*)(lds + ATT_K_OFF); LAS bf16* Vt = (LAS bf16*)(lds + ATT_V_OFF); LAS float* Bl = (LAS float*)(lds + ATT_B_OFF);
#pragma unroll
    for (int i = 0; i < 4; ++i) { const int id = tid + 512 * i, row = id >> 3, ch = id & 7; *(LAS v4u*)(Ks + row * ATT_KS + ch * 8) = st.k[i]; }
#pragma unroll
    for (int i = 0; i < 2; ++i) { const int id = tid + 512 * i, kp = id & 127, ch = id >> 7;
        const unsigned a0[4] = {st.v0[i].x, st.v0[i].y, st.v0[i].z, st.v0[i].w}, a1[4] = {st.v1[i].x, st.v1[i].y, st.v1[i].z, st.v1[i].w};
#pragma unroll
        for (int j = 0; j < 4; ++j) { const unsigned lo = (a0[j] & 0xffffu) | (a1[j] << 16), hi = (a0[j] >> 16) | (a1[j] & 0xffff0000u);
            *(LAS unsigned*)(Vt + (ch * 8 + 2 * j) * ATT_VS + 2 * kp) = lo; *(LAS unsigned*)(Vt + (ch * 8 + 2 * j + 1) * ATT_VS + 2 * kp) = hi; } }
    { const int hh = tid >> 7, d = tid & 127; Bl[hh * 176 + 16 + d] = st.bias; }
    LDS_WAIT(); __syncthreads();
    if (has_next) attn_stage_load(st, KV, RB, nb, nqb, nkvh, tid);
    const int hh = wid >> 1, head = kvh * 4 + hh; const float sink2 = sinks[head] * LOG2E;
    const LAS float* blp = Bl + hh * 176 + 16 + 128 + fr - 4 * fq;
#pragma unroll 1
    for (int it = 0; it < 4; ++it) {
        const int q0 = 64 * (wid & 1) + 16 * it, kt0 = q0 >> 4;
        const bf16* qp = Q + (tok0 + q0 + fr) * 512 + head * 64 + 8 * fq;
        const bf16x8 qf0 = *(const GAS bf16x8*)qp, qf1 = *(const GAS bf16x8*)(qp + 32);
        const float zz = pg8::opaque_f(0.f); const f32x4 zero4 = (f32x4){zz, zz, zz, zz};
        f32x4 st[9]; float mx = -3.0e38f;
#pragma unroll
        for (int t = 0; t < 9; ++t) {
            const LAS bf16* kp = Ks + (16 * (kt0 + t) + fr) * ATT_KS + 8 * fq;
            const bf16x8 k0 = *(const LAS bf16x8*)kp, k1 = *(const LAS bf16x8*)(kp + 32);
            f32x4 s = __builtin_amdgcn_mfma_f32_16x16x32_bf16(k0, qf0, zero4, 0, 0, 0);
            s = __builtin_amdgcn_mfma_f32_16x16x32_bf16(k1, qf1, s, 0, 0, 0);
            const bool tile_ok = (s0 + 16 * (kt0 + t) - 128 >= 0);
#pragma unroll
            for (int r = 0; r < 4; ++r) { const int dist = 128 + fr - 4 * fq - 16 * t - r; const float bv = blp[-16 * t - r];
                const bool ok = tile_ok && dist >= 0 && dist < 128; s[r] = ok ? s[r] + bv : -3.0e38f; mx = fmaxf(mx, s[r]); }
            st[t] = s;
        }
        mx = fmaxf(mx, pg8::shx(mx, 16, lane)); mx = fmaxf(mx, pg8::shx(mx, 32, lane)); mx = fmaxf(mx, sink2);
        float sum = 0.f;
#pragma unroll
        for (int t = 0; t < 9; ++t)
#pragma unroll
            for (int r = 0; r < 4; ++r) { const float p = __builtin_amdgcn_exp2f(st[t][r] - mx); st[t][r] = p; sum += p; }
        sum += pg8::shx(sum, 16, lane); sum += pg8::shx(sum, 32, lane);
        const float inv = 1.0f / (sum + __builtin_amdgcn_exp2f(sink2 - mx));
        f32x4 ot[4];
#pragma unroll
        for (int dt = 0; dt < 4; ++dt) ot[dt] = zero4;
#pragma unroll
        for (int k = 0; k < 5; ++k) {
            v4u pw; pw.x = pg8::cvt_pk_bf16(st[2 * k][0], st[2 * k][1]); pw.y = pg8::cvt_pk_bf16(st[2 * k][2], st[2 * k][3]);
            if (k < 4) { pw.z = pg8::cvt_pk_bf16(st[2 * k + 1][0], st[2 * k + 1][1]); pw.w = pg8::cvt_pk_bf16(st[2 * k + 1][2], st[2 * k + 1][3]); } else { pw.z = 0u; pw.w = 0u; }
            const bf16x8 pb = __builtin_bit_cast(bf16x8, pw);
#pragma unroll
            for (int dt = 0; dt < 4; ++dt) {
                const LAS bf16* vp = Vt + (16 * dt + fr) * ATT_VS + 16 * (kt0 + 2 * k) + 4 * fq;
                const v2u a = *(const LAS v2u*)vp; v2u c = (v2u){0u, 0u}; if (k < 4) c = *(const LAS v2u*)(vp + 16);
                const v4u av = (v4u){a.x, a.y, c.x, c.y};
                ot[dt] = __builtin_amdgcn_mfma_f32_16x16x32_bf16(__builtin_bit_cast(bf16x8, av), pb, ot[dt], 0, 0, 0);
            }
        }
        bf16* op = AO + (tok0 + q0 + fr) * 512 + head * 64 + 4 * fq;
#pragma unroll
        for (int dt = 0; dt < 4; ++dt) { v2u w; w.x = pg8::cvt_pk_bf16(ot[dt][0] * inv, ot[dt][1] * inv); w.y = pg8::cvt_pk_bf16(ot[dt][2] * inv, ot[dt][3] * inv); *(GAS v2u*)(op + 16 * dt) = w; }
    }
    __syncthreads();
}

__device__ __forceinline__ void scan_chain(const float* SL, bf16* UG, f32x2 aL, int g, int b, int lane) {
    const size_t row0 = (size_t)g * 2048 + b * 128;
    float xr = 0.f, xi = 0.f;
    float cr[8], ci[8], nr[8], ni[8];
#pragma unroll
    for (int k = 0; k < 8; ++k) { cr[k] = SL[(row0 + k) * 128 + lane]; ci[k] = SL[(row0 + k) * 128 + 64 + lane]; }
#pragma unroll 1
    for (int c0 = 0; c0 < NCHUNK; c0 += 8) {
        if (c0 + 8 < NCHUNK) {
#pragma unroll
            for (int k = 0; k < 8; ++k) { nr[k] = SL[(row0 + c0 + 8 + k) * 128 + lane]; ni[k] = SL[(row0 + c0 + 8 + k) * 128 + 64 + lane]; }
        }
#pragma unroll
        for (int k = 0; k < 8; ++k) {
            bf16* up = UG + (row0 + c0 + k) * UGLD + 256;
            up[lane] = (bf16)f2bf(xr); up[64 + lane] = (bf16)f2bf(xi);
            const float tr = aL.x * xr - aL.y * xi + cr[k], ti = aL.x * xi + aL.y * xr + ci[k]; xr = tr; xi = ti;
        }
#pragma unroll
        for (int k = 0; k < 8; ++k) { cr[k] = nr[k]; ci[k] = ni[k]; }
    }
}

struct RowRaw { v2u w[4]; };
__device__ __forceinline__ void row_load(RowRaw& r, const bf16* p, int lane) {
#pragma unroll
    for (int j = 0; j < 4; ++j) r.w[j] = *(const GAS v2u*)(p + 256 * j + 4 * lane);
}
__device__ __forceinline__ void row_unpack(f32x4 (&v)[4], const RowRaw& r) {
#pragma unroll
    for (int j = 0; j < 4; ++j) v[j] = (f32x4){pg8::bf_lo(r.w[j].x), pg8::bf_hi(r.w[j].x), pg8::bf_lo(r.w[j].y), pg8::bf_hi(r.w[j].y)};
}
__device__ __forceinline__ void route_row(const f32x4 (&v)[4], const LAS float* rt, int lane, int& e1, int& e2, float& g1, float& g2) {
    float s[8];
#pragma unroll
    for (int e = 0; e < 8; ++e) { float a = 0.f;
#pragma unroll
        for (int j = 0; j < 4; ++j) { const f32x4 w = *(const LAS f32x4*)(rt + e * DM + 256 * j + 4 * lane); a += (v[j].x * w.x + v[j].y * w.y) + (v[j].z * w.z + v[j].w * w.w); }
        s[e] = a; }
    const bool b5 = (lane & 32) != 0, b4 = (lane & 16) != 0, b3 = (lane & 8) != 0;
    float r[4], q[2];
#pragma unroll
    for (int i = 0; i < 4; ++i) { const float mine = b5 ? s[i + 4] : s[i], other = b5 ? s[i] : s[i + 4]; r[i] = mine + pg8::shx(other, 32, lane); }
#pragma unroll
    for (int i = 0; i < 2; ++i) { const float mine = b4 ? r[i + 2] : r[i], other = b4 ? r[i] : r[i + 2]; q[i] = mine + pg8::shx(other, 16, lane); }
    float w = (b3 ? q[1] : q[0]) + pg8::shx(b3 ? q[0] : q[1], 8, lane);
    w += pg8::shx(w, 4, lane); w += pg8::shx(w, 2, lane); w += pg8::shx(w, 1, lane);
    float lg[8];
#pragma unroll
    for (int e = 0; e < 8; ++e) lg[e] = __uint_as_float((unsigned)__builtin_amdgcn_readlane((int)__float_as_uint(w), 8 * e));
    e1 = 0; float v1 = lg[0];
#pragma unroll
    for (int e = 1; e < 8; ++e) if (lg[e] > v1) { v1 = lg[e]; e1 = e; }
    e2 = -1; float v2 = -3.0e38f;
#pragma unroll
    for (int e = 0; e < 8; ++e) if (e != e1 && lg[e] > v2) { v2 = lg[e]; e2 = e; }
    g1 = 1.0f / (1.0f + __expf(v2 - v1)); g2 = 1.0f - g1;
}
__device__ __forceinline__ void ln_load_bf16(f32x4 (&v)[4], const bf16* hrow, int lane) {
#pragma unroll
    for (int j = 0; j < 4; ++j) { const v2u w = *(const GAS v2u*)(hrow + 256 * j + 4 * lane); v[j] = (f32x4){pg8::bf_lo(w.x), pg8::bf_hi(w.x), pg8::bf_lo(w.y), pg8::bf_hi(w.y)}; }
}
__device__ __forceinline__ void ln_finish(f32x4 (&v)[4], const float* gam, const float* bet, float* outrow, bf16* xbrow, int lane) {
    float s = 0.f;
#pragma unroll
    for (int j = 0; j < 4; ++j) s += (v[j].x + v[j].y) + (v[j].z + v[j].w);
    const float mean = wave_sum(s, lane) * (1.f / DM); float s2 = 0.f;
#pragma unroll
    for (int j = 0; j < 4; ++j) { v[j] = v[j] - mean; s2 += (v[j].x * v[j].x + v[j].y * v[j].y) + (v[j].z * v[j].z + v[j].w * v[j].w); }
    const float rstd = 1.f / sqrtf(wave_sum(s2, lane) * (1.f / DM) + LN_EPS);
#pragma unroll
    for (int j = 0; j < 4; ++j) { const f32x4 gg = *(const GAS f32x4*)(gam + 256 * j + 4 * lane), bb = *(const GAS f32x4*)(bet + 256 * j + 4 * lane);
        v[j] = v[j] * rstd * gg + bb;
        if (outrow) *(GAS f32x4*)(outrow + 256 * j + 4 * lane) = v[j];
        v2u w; w.x = pk2(v[j].x, v[j].y); w.y = pk2(v[j].z, v[j].w); *(GAS v2u*)(xbrow + 256 * j + 4 * lane) = w; }
}

constexpr int NPH = 11;
__global__ void __launch_bounds__(NWAVES * 64, 2) fwd(Args args) {
    extern __shared__ __attribute__((aligned(16))) unsigned char lds_raw[];
    LAS unsigned char* lds = (LAS unsigned char*)lds_raw;
    volatile LAS unsigned* MISC = (volatile LAS unsigned*)(lds + MISC_OFF);
    const int G = gridDim.x, wave0 = __builtin_amdgcn_readfirstlane(threadIdx.x >> 6);
    { const int tid = threadIdx.x;
#define ctl WSP(unsigned, WS_CTL)
    for (int u = tid; u < (LDS_BYTES - LDSCTL_OFF) / 4; u += NWAVES * 64) ((LAS unsigned*)(lds + LDSCTL_OFF))[u] = 0u; }
    __syncthreads();
    XcdBarrier bar; bar.bar = (unsigned*)ctl + CW_BAR; bar.x = 0; bar.st = nullptr;
    if (!MK_PER_PHASE) bar = xcd_barrier_post((unsigned*)ctl + CW_BAR, MISC + 8, wave0 * 64 + pg8::lane_id());
    const int lo = args.ph_lo, hi = args.ph_hi;
#define IN(k) (lo <= (k) && (k) < hi)
#define SEAM(k) do { if (!MK_PER_PHASE && IN((k) + 1)) xcd_barrier(bar, wave0 * 64 + pg8::lane_id()); } while (0)
#define PHASE_IDS const int lane = pg8::lane_id(), wave = wave0, tid = wave * 64 + lane, bx = pg8::opaque_s(blockIdx.x), gw = bx * NWAVES + wave, NGW = G * NWAVES; (void)lane; (void)gw; (void)NGW

#define WIN WSP(bf16, WS_WIN)
#define WGLU WSP(bf16, WS_WGLU)
#define WBA WSP(bf16, WS_WBA)
#define WBS WSP(bf16, WS_WBS)
#define WOUT WSP(bf16, WS_WOUT)
#define WGU WSP(bf16, WS_WGU)
#define WDN WSP(bf16, WS_WDN)
#define MGU WSP(bf16, WS_MGU)
#define MDN WSP(bf16, WS_MDN)
#define PPJ WSP(bf16, WS_PPJ)
#define PGT WSP(bf16, WS_PGT)
#define SGm WSP(bf16, WS_SG)
#define TZE WSP(bf16, WS_TZE)
#define LAML WSP(f32x2, WS_MISC)
#define RB WSP(float, WS_MISC + 65536)
#define TOKE WSP(int, WS_MISC + 131072)
#define TOKG WSP(float, WS_MISC + 393216)
#define TOKP WSP(int, WS_MISC + 655360)
#define PB WSP(bf16, WS_PB)
#define XB WSP(bf16, WS_XB)
#define PP WSP(bf16, WS_PP)
#define XS WSP(bf16, WS_XS)
#define XIDX WSP(int, WS_XS + 256 * MiB)
#define Qb WSP(bf16, WS_Q)
#define KVb WSP(bf16, WS_KV)
#define UG WSP(bf16, WS_UG)
#define GAb WSP(bf16, WS_GA)
#define GSb WSP(bf16, WS_GS)
#define SL WSP(float, WS_SL)
#define AO WSP(bf16, WS_AO)
#define YB WSP(bf16, WS_YB)
#define SO WSP(bf16, WS_SO)
#define T1 WSP(bf16, WS_T1)
#define MG WSP(bf16, WS_MG)
#define HB WSP(bf16, WS_HB)
#define HBUF WSP(bf16, WS_HBUF)
#define R out_ptr()

    if (IN(0)) {
        PHASE_IDS; const size_t gtid = (size_t)bx * 512 + tid, gthreads = (size_t)G * 512;
        LAS float* scr = (LAS float*)(lds + RING_OFF + wave * 16384);
        for (int task = bx; task < DEPTH * 32; task += G) ssm_build(lds, task >> 5, task & 31, tid);
        if (bx == G - 1) { for (int i = tid; i < 8 * 128; i += 512) { const int h = i >> 7, d = i & 127; int bk = d;
                if (d >= 16) { bk = 16 + (int)(log((double)d / 16.0) / log(8.0) * 16.0); bk = bk > 31 ? 31 : bk; }
                RB[i] = in_ptr(I_RELB)[bk * 8 + h] * LOG2E; } }
        __syncthreads();
        {
            TrItem d0 = {nullptr, nullptr, 0, 0}; float r0[32];
#pragma unroll
            for (int i = 0; i < 32; ++i) r0[i] = 0.f;
            if (gw < TR_NIT) { tr_desc(d0, gw); tr_load(r0, d0, lane); }
#pragma unroll 1
            for (int it = gw; it < TR_NIT; it += NGW) {
                TrItem d1 = d0; float r1[32];
#pragma unroll
                for (int i = 0; i < 32; ++i) r1[i] = r0[i];
                if (it + NGW < TR_NIT) { tr_desc(d1, it + NGW); tr_load(r1, d1, lane); }
                tr_store(r0, d0, scr, lane);
                d0 = d1;
#pragma unroll
                for (int i = 0; i < 32; ++i) r0[i] = r1[i];
            }
        }
        cvt_rows(in_ptr(I_P), PB, (size_t)DEPTH * T * PLE / 8, gtid, gthreads);
        cvt_rows(in_ptr(I_X), XB, (size_t)T * DM / 8, gtid, gthreads);
        SEAM(0);
    }

#pragma unroll 1
    for (int l = 0; l < DEPTH; ++l) {
        const int P0 = 1 + l * NPH;
        const bool moe = (l & 1) != 0; const int l2 = l >> 1;
        if (IN(P0 + 0)) {
            PHASE_IDS;
            pg8::Gemm g{XB, WIN + (size_t)l * IN_COLS * 1024, 1024, 1024, 1024}; pg8::StaticOrder S; S.init(T, IN_COLS, G, bx);
            pg8::EpiInProj E{Qb, KVb, UG, GAb, GSb};
            pg8::gemm_phase<pg8::EpiInProj, pg8::StaticOrder, true, true>(lds + RING_OFF, g, S, E, tid);
            { pg8::Gemm g2{PB + (size_t)l * T * PLE, PPJ + (size_t)l * 1024 * PLE, PLE, PLE, pg8::opaque_s(PLE)}; pg8::StaticOrder S2; pg8::init_short(S2, T, 1024, G, bx, ((T / 256) * (IN_COLS / 256)) % G);
              pg8::EpiEw<0> E2{PP, 1024, nullptr, nullptr, nullptr};
              pg8::gemm_phase<pg8::EpiEw<0>, pg8::StaticOrder, true, true>(lds + RING_OFF, g2, S2, E2, tid); }
            SEAM(P0 + 0);
        }
        if (IN(P0 + 1)) {
            PHASE_IDS;
            { pg8::Gemm g{UG, SGm + (size_t)l * 32 * 256 * 256, UGLD, 256, 256}; pg8::GroupOrder S; S.init(UGROWS / 256, 3, G, bx);
              pg8::EpiS E{SL};
              pg8::gemm_phase<pg8::EpiS, pg8::GroupOrder, true, true>(lds + RING_OFF, g, S, E, tid); }
            SEAM(P0 + 1);
        }
        if (IN(P0 + 2)) {
            PHASE_IDS;
            if (wave < 2) { for (int ch = bx * 2 + wave; ch < 32 * BATCH; ch += 2 * G) { const int g = ch >> 4, b = ch & 15; scan_chain(SL, UG, LAML[(l * 32 + g) * 64 + lane], g, b, lane); } }
            { AttStage st = {}; const int NU = BATCH * 16 * 2;
              if (bx < NU) attn_stage_load(st, KVb, RB, bx >> 5, (bx >> 1) & 15, bx & 1, tid);
              for (int un = bx; un < NU; un += G) { const int kvh = un & 1, qb = (un >> 1) & 15, b = un >> 5, nu = un + G; const bool hn = nu < NU;
                attn_unit(lds + RING_OFF, st, Qb, KVb, AO, RB, in_ptr(I_SINKS) + l * 8, b, qb, kvh, hn, nu >> 5, (nu >> 1) & 15, nu & 1, tid); } }
            SEAM(P0 + 2);
        }
        if (IN(P0 + 3)) {
            PHASE_IDS;
            pg8::Gemm g{UG, TZE + (size_t)l * 32 * 256 * 384, UGLD, 384, 384}; pg8::GroupOrder S; S.init(UGROWS / 256, 3, G, bx);
            pg8::EpiY E{UG, in_ptr(I_SSMD) + l * 512, YB};
            pg8::gemm_phase<pg8::EpiY, pg8::GroupOrder, true, true>(lds + RING_OFF, g, S, E, tid);
            SEAM(P0 + 3);
        }
        if (IN(P0 + 4)) {
            PHASE_IDS;
            { pg8::Gemm g{YB, WGLU + (size_t)l * 512 * 512, 512, 512, 512}; pg8::StaticOrder S; S.init(T, 512, G, bx);
              pg8::EpiEw<1> E{SO, 512, YB, nullptr, in_ptr(I_BGLU) + l * 512};
              pg8::gemm_phase<pg8::EpiEw<1>, pg8::StaticOrder, true, true>(lds + RING_OFF, g, S, E, tid); }
            { pg8::Gemm g{AO, WBA + (size_t)l * 1024 * 512, 512, 512, 512}; pg8::StaticOrder S; S.init(T, 1024, G, bx);
              pg8::EpiEw<2> E{T1, 1024, GAb, nullptr, nullptr};
              pg8::gemm_phase<pg8::EpiEw<2>, pg8::StaticOrder, true, true>(lds + RING_OFF, g, S, E, tid); }
            SEAM(P0 + 4);
        }
        if (IN(P0 + 5)) {
            PHASE_IDS;
            pg8::Gemm g{SO, WBS + (size_t)l * 1024 * 512, 512, 512, 512}; pg8::StaticOrder S; S.init(T, 1024, G, bx);
            pg8::EpiEw<3> E{MG, 1024, GSb, T1, nullptr};
            pg8::gemm_phase<pg8::EpiEw<3>, pg8::StaticOrder, true, true>(lds + RING_OFF, g, S, E, tid);
            SEAM(P0 + 5);
        }
        if (IN(P0 + 6)) {
            PHASE_IDS;
            pg8::Gemm g{MG, WOUT + (size_t)l * 1024 * 1024, 1024, 1024, 1024}; pg8::StaticOrder S; S.init(T, 1024, G, bx);
            pg8::EpiEw<5> E{HBUF, 1024, XB, nullptr, nullptr};
            pg8::gemm_phase<pg8::EpiEw<5>, pg8::StaticOrder, true, true>(lds + RING_OFF, g, S, E, tid);
            SEAM(P0 + 6);
        }
        if (IN(P0 + 7)) {
            PHASE_IDS;
            const float* gam = in_ptr(I_LN1G) + l * DM; const float* bet = in_ptr(I_LN1B) + l * DM;
            LAS float* rt = (LAS float*)(lds + RING_OFF);
            if (moe) { const float* rw = in_ptr(I_ROUTER) + (size_t)l2 * DM * NEXP; for (int i = tid; i < DM * NEXP; i += 512) rt[(i & 7) * DM + (i >> 3)] = rw[i]; LDS_WAIT(); __syncthreads(); }
            unsigned* cur = (unsigned*)ctl + CW_MOE + (l2 * 16 + 8) * 64;
            for (int base = gw * 16; base < T; base += NGW * 16) {
                int ev = -1;
                RowRaw ca, cb; row_load(ca, HBUF + (size_t)base * DM, lane); row_load(cb, HBUF + (size_t)(base + 1) * DM, lane);
#pragma unroll 1
                for (int k = 0; k < 16; k += 2) { const int row = base + k;
                    RowRaw na = ca, nb = cb;
                    if (k + 2 < 16) { row_load(na, HBUF + (size_t)(row + 2) * DM, lane); row_load(nb, HBUF + (size_t)(row + 3) * DM, lane); }
                    f32x4 va[4], vb[4]; row_unpack(va, ca); row_unpack(vb, cb);
                    ln_finish(va, gam, bet, nullptr, XB + (size_t)row * DM, lane);
                    ln_finish(vb, gam, bet, nullptr, XB + (size_t)(row + 1) * DM, lane);
                    if (moe) {
                        int a1, a2, b1, b2; float ga1, ga2, gb1, gb2;
                        route_row(va, rt, lane, a1, a2, ga1, ga2); route_row(vb, rt, lane, b1, b2, gb1, gb2);
                        if (lane == 0) { TOKE[row * 2] = a1; TOKE[row * 2 + 1] = a2; TOKG[row * 2] = ga1; TOKG[row * 2 + 1] = ga2; TOKE[row * 2 + 2] = b1; TOKE[row * 2 + 3] = b2; TOKG[row * 2 + 2] = gb1; TOKG[row * 2 + 3] = gb2; }
                        if (lane == 2 * k) ev = a1; if (lane == 2 * k + 1) ev = a2; if (lane == 2 * k + 2) ev = b1; if (lane == 2 * k + 3) ev = b2;
                    }
                    ca = na; cb = nb;
                }
                if (moe) {
                    int rank = 0, mycnt = 0;
#pragma unroll
                    for (int x = 0; x < 8; ++x) { const unsigned long long mask = __ballot(ev == x); if (ev == x) rank = __popcll(mask & ((1ull << lane) - 1ull)); if (lane == x) mycnt = __popcll(mask); }
                    int old = 0; if (lane < 8 && mycnt) old = (int)xb_add(cur + lane * 64, (unsigned)mycnt);
                    const int pos = __builtin_amdgcn_ds_bpermute((ev < 0 ? 0 : ev) << 2, old) + rank;
                    if (lane < 32) { TOKP[base * 2 + lane] = pos; XIDX[(size_t)ev * T + pos] = base + (lane >> 1); }
                }
            }
            __syncthreads();
            SEAM(P0 + 7);
        }
        int tb1 = 0, tb2 = 0, tb3 = 0, tb4 = 0, tb5 = 0, tb6 = 0, tb7 = 0, NT = 0;
        if (moe && hi > P0 + 7) { unsigned* cw = (unsigned*)ctl + CW_MOE + (l2 * 16 + 8) * 64; int t = 0;
            t += ((int)xb_ld(cw + 0 * 64) + 255) >> 8; tb1 = t; t += ((int)xb_ld(cw + 1 * 64) + 255) >> 8; tb2 = t; t += ((int)xb_ld(cw + 2 * 64) + 255) >> 8; tb3 = t;
            t += ((int)xb_ld(cw + 3 * 64) + 255) >> 8; tb4 = t; t += ((int)xb_ld(cw + 4 * 64) + 255) >> 8; tb5 = t; t += ((int)xb_ld(cw + 5 * 64) + 255) >> 8; tb6 = t;
            t += ((int)xb_ld(cw + 6 * 64) + 255) >> 8; tb7 = t; t += ((int)xb_ld(cw + 7 * 64) + 255) >> 8; NT = t;
            tb1 = __builtin_amdgcn_readfirstlane(tb1); tb2 = __builtin_amdgcn_readfirstlane(tb2); tb3 = __builtin_amdgcn_readfirstlane(tb3); tb4 = __builtin_amdgcn_readfirstlane(tb4);
            tb5 = __builtin_amdgcn_readfirstlane(tb5); tb6 = __builtin_amdgcn_readfirstlane(tb6); tb7 = __builtin_amdgcn_readfirstlane(tb7); NT = __builtin_amdgcn_readfirstlane(NT); }
        if (IN(P0 + 8)) {
            PHASE_IDS;
            if (!moe) { pg8::Gemm g{XB, WGU + (size_t)l2 * 2 * DFF * 1024, 1024, 1024, 1024}; pg8::StaticOrder S; S.init(T, 2 * DFF, G, bx);
                pg8::EpiSwiGLU E{HB, DFF};
                pg8::gemm_phase<pg8::EpiSwiGLU, pg8::StaticOrder, true, true>(lds + RING_OFF, g, S, E, tid);
                { pg8::Gemm g2{XB, PGT + (size_t)l * 1024 * 1024, 1024, 1024, 1024}; pg8::StaticOrder S2; S2.init(T, 1024, G, bx);
                  pg8::EpiEw<4> E2{PP, 1024, nullptr, nullptr, nullptr};
                  pg8::gemm_phase<pg8::EpiEw<4>, pg8::StaticOrder, true, true>(lds + RING_OFF, g2, S2, E2, tid); } }
            else { pg8::Gemm g{XB, MGU + (size_t)l2 * NEXP * 2 * DFFE * 1024, 1024, 1024, 1024};
                pg8::MoeOrder S{NT, 2 * DFFE / 256, NT * (2 * DFFE / 256), G, bx, T / 256, tb1, tb2, tb3, tb4, tb5, tb6, tb7};
                pg8::EpiSwiGLU E{HB, DFFE};
                pg8::gemm_phase<pg8::EpiSwiGLU, pg8::MoeOrder, true, true, true>(lds + RING_OFF, g, S, E, tid, XIDX, T - 1); }
            SEAM(P0 + 8);
        }
        if (IN(P0 + 9)) {
            PHASE_IDS;
            if (!moe) { pg8::Gemm g{HB, WDN + (size_t)l2 * 1024 * DFF, DFF, DFF, DFF}; pg8::StaticOrder S; S.init(T, 1024, G, bx);
                pg8::EpiEw<6> E{HBUF, 1024, XB, PP, nullptr};
                pg8::gemm_phase<pg8::EpiEw<6>, pg8::StaticOrder, true, true>(lds + RING_OFF, g, S, E, tid); }
            else { pg8::Gemm g{HB, MDN + (size_t)l2 * NEXP * 1024 * DFFE, DFFE, DFFE, DFFE};
                pg8::MoeOrder S{NT, 4, NT * 4, G, bx, 0, tb1, tb2, tb3, tb4, tb5, tb6, tb7};
                pg8::EpiEw<0> E{XS, 1024, nullptr, nullptr, nullptr};
                pg8::gemm_phase<pg8::EpiEw<0>, pg8::MoeOrder, true, true>(lds + RING_OFF, g, S, E, tid);
                { pg8::Gemm g2{XB, PGT + (size_t)l * 1024 * 1024, 1024, 1024, 1024}; pg8::StaticOrder S2; pg8::init_short(S2, T, 1024, G, bx, (NT * 4) % G);
                  pg8::EpiEw<4> E2{PP, 1024, nullptr, nullptr, nullptr};
                  pg8::gemm_phase<pg8::EpiEw<4>, pg8::StaticOrder, true, true>(lds + RING_OFF, g2, S2, E2, tid); } }
            SEAM(P0 + 9);
        }
        if (IN(P0 + 10)) {
            PHASE_IDS;
            const float* gam = in_ptr(I_LN2G) + l * DM; const float* bet = in_ptr(I_LN2B) + l * DM;
            for (int base = gw * 16; base < T; base += NGW * 16) {
                int tp = 0; float tg = 0.f;
                if (moe && lane < 32) { const int te = TOKE[base * 2 + lane]; tg = TOKG[base * 2 + lane];
                    tp = TOKP[base * 2 + lane] + 256 * (te == 0 ? 0 : te == 1 ? tb1 : te == 2 ? tb2 : te == 3 ? tb3 : te == 4 ? tb4 : te == 5 ? tb5 : te == 6 ? tb6 : tb7); }
                const bf16* xsrc = moe ? XB : HBUF;
                RowRaw cx[2] = {}, cy[2][2] = {}, cp[2] = {};
#define LN2_LOAD(dx, dy, dp, r0) do { _Pragma("unroll") for (int q_ = 0; q_ < 2; ++q_) { const int row_ = (r0) + q_; row_load(dx[q_], xsrc + (size_t)row_ * DM, lane); \
                    if (moe) { const int kk_ = row_ - base; const int p1_ = __builtin_amdgcn_readlane(tp, 2 * kk_), p2_ = __builtin_amdgcn_readlane(tp, 2 * kk_ + 1); \
                        row_load(dy[q_][0], XS + (size_t)p1_ * DM, lane); row_load(dy[q_][1], XS + (size_t)p2_ * DM, lane); row_load(dp[q_], PP + (size_t)row_ * DM, lane); } } } while (0)
                LN2_LOAD(cx, cy, cp, base);
#pragma unroll 1
                for (int k = 0; k < 16; k += 2) { const int row = base + k;
                    RowRaw nx[2], ny[2][2], np[2];
#pragma unroll
                    for (int q = 0; q < 2; ++q) { nx[q] = cx[q]; np[q] = cp[q]; ny[q][0] = cy[q][0]; ny[q][1] = cy[q][1]; }
                    if (k + 2 < 16) LN2_LOAD(nx, ny, np, row + 2);
#pragma unroll
                    for (int q = 0; q < 2; ++q) { f32x4 v[4]; row_unpack(v, cx[q]);
                        if (moe) { f32x4 fa[4], fb[4], fc[4]; row_unpack(fa, cy[q][0]); row_unpack(fb, cy[q][1]); row_unpack(fc, cp[q]);
                            const float g1 = __uint_as_float((unsigned)__builtin_amdgcn_readlane((int)__float_as_uint(tg), 2 * (k + q))), g2 = __uint_as_float((unsigned)__builtin_amdgcn_readlane((int)__float_as_uint(tg), 2 * (k + q) + 1));
#pragma unroll
                            for (int j = 0; j < 4; ++j) v[j] = v[j] * ALPHA + fa[j] * g1 + fb[j] * g2 + fc[j]; }
                        ln_finish(v, gam, bet, l + 1 < DEPTH ? nullptr : R + (size_t)(row + q) * DM, XB + (size_t)(row + q) * DM, lane); }
#pragma unroll
                    for (int q = 0; q < 2; ++q) { cx[q] = nx[q]; cp[q] = np[q]; cy[q][0] = ny[q][0]; cy[q][1] = ny[q][1]; }
                }
#undef LN2_LOAD
            }
            SEAM(P0 + 10);
        }
    }
#undef IN
#undef SEAM
}

extern "C" void kernel_launch(void* const* d_in, const int* in_sizes, int n_in, void* d_out, int out_size, void* d_ws, size_t ws_size, hipStream_t stream) {
    static int grid = 0;
    if (grid == 0) {
        if (n_in != 29 || out_size != T * DM || ws_size < WS_END) { fprintf(stderr, "kernel_launch: unexpected shapes (n_in %d, out %d, ws %zu, need %zu)\n", n_in, out_size, ws_size, (size_t)WS_END); grid = -1; return; }
        int dev = 0, cus = 0, per_cu = 0;
        if (hipGetDevice(&dev) != hipSuccess || hipDeviceGetAttribute(&cus, hipDeviceAttributeMultiprocessorCount, dev) != hipSuccess) { grid = -1; return; }
        if (hipFuncSetAttribute((const void*)fwd, hipFuncAttributeMaxDynamicSharedMemorySize, LDS_BYTES) != hipSuccess) { fprintf(stderr, "kernel_launch: hipFuncSetAttribute failed\n"); grid = -1; return; }
        if (hipOccupancyMaxActiveBlocksPerMultiprocessor(&per_cu, (const void*)fwd, NWAVES * 64, LDS_BYTES) != hipSuccess || per_cu < 1) fprintf(stderr, "kernel_launch: occupancy query reports %d\n", per_cu);
        (void)hipGetLastError();
        grid = cus;
    }
    if (grid < 0) return;
    if (hipMemsetAsync((char*)d_ws + WS_CTL, 0, CTL_ZERO_BYTES, stream) != hipSuccess) { fprintf(stderr, "kernel_launch: memset failed\n"); return; }
    Args a{};
    for (int i = 0; i < 29; ++i) a.in[i] = (const float*)d_in[i];
    a.out = (float*)d_out; a.ws = (unsigned char*)d_ws;
    const int NPHASES = 1 + DEPTH * NPH;
#if MK_PER_PHASE
    for (int ph = 0; ph < NPHASES; ++ph) { a.ph_lo = ph; a.ph_hi = ph + 1; hipLaunchKernelGGL(fwd, dim3(grid), dim3(NWAVES * 64), LDS_BYTES, stream, a); }
#else
    a.ph_lo = 0; a.ph_hi = NPHASES;
    hipLaunchKernelGGL(fwd, dim3(grid), dim3(NWAVES * 64), LDS_BYTES, stream, a);
#endif
    const hipError_t le = hipPeekAtLastError();
    if (le != hipSuccess) fprintf(stderr, "kernel_launch: launch failed: %s\n", hipGetErrorName(le));
}
```
